# Optimizing an MI355X kernel written in HIP

```python
import jax, jax.numpy as jnp
from jax import lax
import numpy as np

D_MODEL = 1024
BATCH = 8
SEQ = 8192
DEPTH = 1

D_FF = 2816
MACARON_WEIGHT = 0.5
NORM_EPS = 1e-6
GLA_HEADS = 4
GLA_DK = 64
GLA_DV = 128
GLA_GATE_RANK = 16
GLA_GATE_NORMALIZER = 16.0
GLA_CHUNK = 64
RWKV_HEADS = 8
RWKV_N = 64
RWKV_DECAY_RANK = 64
RWKV_AAA_RANK = 64
RWKV_GATE_RANK = 128
RWKV_GN_EPS = 64e-5
GLA_WIDTH = GLA_HEADS * GLA_DV
RWKV_WIDTH = RWKV_HEADS * RWKV_N
MIX_WIDTH = GLA_WIDTH + RWKV_WIDTH
GLA_COLS = (GLA_HEADS * GLA_DK, GLA_HEADS * GLA_DK, GLA_WIDTH, GLA_WIDTH, GLA_GATE_RANK)
RWKV_COLS = (RWKV_WIDTH, RWKV_WIDTH, RWKV_WIDTH, RWKV_DECAY_RANK, RWKV_AAA_RANK, RWKV_GATE_RANK)
GLA_PROJ = 2 * GLA_HEADS * GLA_DK + 2 * GLA_WIDTH + GLA_GATE_RANK
RWKV_PROJ = 3 * RWKV_WIDTH + RWKV_DECAY_RANK + RWKV_AAA_RANK + RWKV_GATE_RANK
PROJ_WIDTH = GLA_PROJ + RWKV_PROJ

kernel_name = "hybrid_gla_rwkv7_macaron_block"


def _rms_norm(x, g):
    xf = x.astype(jnp.float32)
    y = xf * lax.rsqrt(jnp.mean(xf * xf, axis=-1, keepdims=True) + NORM_EPS)
    return (y * g.astype(jnp.float32)).astype(x.dtype)


def _swiglu(h, w_gate, w_up, w_down):
    return (jax.nn.silu(h @ w_gate) * (h @ w_up)) @ w_down


def _split_cols(t, sizes):
    return jnp.split(t, np.cumsum(sizes)[:-1].tolist(), axis=-1)


def _gla_mixer(q, k, v, g_out, a_lr, alpha_w2, alpha_b, norm_w):
    f32 = jnp.float32
    bsz, seq, _ = q.shape
    n_chunks = seq // GLA_CHUNK
    log_alpha = jax.nn.log_sigmoid((a_lr @ alpha_w2 + alpha_b).astype(f32)) / GLA_GATE_NORMALIZER

    def to_chunks(t, d):
        return t.astype(f32).reshape(bsz, n_chunks, GLA_CHUNK, GLA_HEADS, d).transpose(1, 0, 3, 2, 4)

    qc = to_chunks(q, GLA_DK) * (GLA_DK ** -0.5)
    kc = to_chunks(k, GLA_DK)
    vc = to_chunks(v, GLA_DV)
    gc = to_chunks(log_alpha, GLA_DK)
    causal = jnp.tril(jnp.ones((GLA_CHUNK, GLA_CHUNK), dtype=bool))[:, :, None]

    def chunk_step(state, inp):
        qb, kb, vb, gb = inp
        cum = jnp.cumsum(gb, axis=2)
        o_inter = jnp.einsum('bhcd,bhdv->bhcv', qb * jnp.exp(cum), state)
        rel = jnp.exp(jnp.where(causal, cum[:, :, :, None, :] - cum[:, :, None, :, :], -jnp.inf))
        scores = jnp.einsum('bhid,bhjd,bhijd->bhij', qb, kb, rel)
        o_intra = jnp.einsum('bhij,bhjv->bhiv', scores, vb)
        last = cum[:, :, -1, :]
        new_state = jnp.exp(last)[..., None] * state + jnp.einsum(
            'bhcd,bhcv->bhdv', kb * jnp.exp(last[:, :, None, :] - cum), vb)
        return new_state, o_inter + o_intra

    state0 = jnp.zeros((bsz, GLA_HEADS, GLA_DK, GLA_DV), f32)
    _, oc = lax.scan(chunk_step, state0, (qc, kc, vc, gc))
    o = oc.transpose(1, 0, 3, 2, 4).reshape(bsz, seq, GLA_HEADS, GLA_DV)
    o = o * lax.rsqrt(jnp.mean(o * o, axis=-1, keepdims=True) + NORM_EPS) * norm_w
    o = o * jax.nn.silu(g_out.astype(f32).reshape(bsz, seq, GLA_HEADS, GLA_DV))
    return o.reshape(bsz, seq, GLA_WIDTH)


def _rwkv7_mixer(p, mu, w0, w2, a0, a2, g2, k_k, k_a, r_k, ln_w, ln_b):
    f32 = jnp.float32
    bsz, seq, _ = p.shape
    p = p.astype(f32)
    p_prev = jnp.pad(p[:, :-1], ((0, 0), (1, 0), (0, 0)))
    p = p + mu * (p_prev - p)
    r, k, v, w_lr, a_lr, g_lr = _split_cols(p, RWKV_COLS)
    w = -jax.nn.softplus(-(w0 + jnp.tanh(w_lr) @ w2)) - 0.5
    decay = jnp.exp(-jnp.exp(w))
    a = jax.nn.sigmoid(a0 + a_lr @ a2)
    g = jax.nn.sigmoid(g_lr) @ g2

    def heads(t):
        return t.reshape(bsz, seq, RWKV_HEADS, RWKV_N)

    kk = heads(k * k_k)
    kk = kk / jnp.maximum(jnp.linalg.norm(kk, axis=-1, keepdims=True), 1e-12)
    k = heads(k * (1.0 + (a - 1.0) * k_a))
    a_h = heads(a)
    r, v, decay = heads(r), heads(v), heads(decay)

    def tm(t):
        return t.transpose(1, 0, 2, 3)

    def step(state, inp):
        r_t, w_t, k_t, v_t, a_t, b_t = inp
        sa = jnp.einsum('bhvk,bhk->bhv', state, a_t)
        state = (state * w_t[:, :, None, :] + sa[..., None] * b_t[:, :, None, :]
                 + v_t[..., None] * k_t[:, :, None, :])
        return state, jnp.einsum('bhvk,bhk->bhv', state, r_t)

    state0 = jnp.zeros((bsz, RWKV_HEADS, RWKV_N, RWKV_N), f32)
    _, y = lax.scan(step, state0, (tm(r), tm(decay), tm(k), tm(v), tm(-kk), tm(kk * a_h)))
    y = tm(y)
    mean = jnp.mean(y, axis=-1, keepdims=True)
    var = jnp.mean(jnp.square(y - mean), axis=-1, keepdims=True)
    y = ((y - mean) * lax.rsqrt(var + RWKV_GN_EPS)).reshape(bsz, seq, RWKV_WIDTH) * ln_w + ln_b
    bonus = jnp.sum(r * k * r_k, axis=-1, keepdims=True) * v
    y = y + bonus.reshape(bsz, seq, RWKV_WIDTH)
    return y * g


def setup_inputs(seed: int = 0) -> dict:
    key = jax.random.key(seed)
    ks = jax.random.split(key, 32)
    f32 = jnp.float32
    L = DEPTH

    def nrm(k, shape, scale):
        return jax.random.normal(k, shape, f32) * scale

    def gain(k, shape):
        return 1.0 + 0.02 * jax.random.normal(k, shape, f32)

    return {
        "x": jax.random.normal(ks[0], (BATCH, SEQ, D_MODEL), f32),
        "ffn1_norm": gain(ks[1], (L, D_MODEL)),
        "ffn1_w_gate": nrm(ks[2], (L, D_MODEL, D_FF), D_MODEL ** -0.5),
        "ffn1_w_up": nrm(ks[3], (L, D_MODEL, D_FF), D_MODEL ** -0.5),
        "ffn1_w_down": nrm(ks[4], (L, D_FF, D_MODEL), D_FF ** -0.5),
        "mix_norm": gain(ks[5], (L, D_MODEL)),
        "w_in": nrm(ks[6], (L, D_MODEL, PROJ_WIDTH), D_MODEL ** -0.5),
        "gla_alpha_w2": nrm(ks[7], (L, GLA_GATE_RANK, GLA_HEADS * GLA_DK), GLA_GATE_RANK ** -0.5),
        "gla_alpha_b": nrm(ks[8], (L, GLA_HEADS * GLA_DK), 0.5),
        "gla_norm": gain(ks[9], (L, GLA_DV)),
        "rwkv_mu": jax.random.uniform(ks[10], (L, RWKV_PROJ), f32, 0.0, 1.0),
        "rwkv_w0": jax.random.uniform(ks[11], (L, RWKV_WIDTH), f32, -4.0, 0.0),
        "rwkv_w2": nrm(ks[12], (L, RWKV_DECAY_RANK, RWKV_WIDTH), 0.5 * RWKV_DECAY_RANK ** -0.5),
        "rwkv_a0": nrm(ks[13], (L, RWKV_WIDTH), 0.5),
        "rwkv_a2": nrm(ks[14], (L, RWKV_AAA_RANK, RWKV_WIDTH), RWKV_AAA_RANK ** -0.5),
        "rwkv_g2": nrm(ks[15], (L, RWKV_GATE_RANK, RWKV_WIDTH), RWKV_GATE_RANK ** -0.5),
        "rwkv_k_k": 0.85 + nrm(ks[16], (L, RWKV_WIDTH), 0.05),
        "rwkv_k_a": 1.0 + nrm(ks[17], (L, RWKV_WIDTH), 0.05),
        "rwkv_r_k": nrm(ks[18], (L, RWKV_HEADS, RWKV_N), 0.1),
        "rwkv_ln_w": gain(ks[19], (L, RWKV_WIDTH)),
        "rwkv_ln_b": nrm(ks[20], (L, RWKV_WIDTH), 0.02),
        "w_out": nrm(ks[21], (L, MIX_WIDTH, D_MODEL), MIX_WIDTH ** -0.5),
        "ffn2_norm": gain(ks[22], (L, D_MODEL)),
        "ffn2_w_gate": nrm(ks[23], (L, D_MODEL, D_FF), D_MODEL ** -0.5),
        "ffn2_w_up": nrm(ks[24], (L, D_MODEL, D_FF), D_MODEL ** -0.5),
        "ffn2_w_down": nrm(ks[25], (L, D_FF, D_MODEL), D_FF ** -0.5),
        "final_norm": gain(ks[26], (D_MODEL,)),
    }


def reference(x, ffn1_norm, ffn1_w_gate, ffn1_w_up, ffn1_w_down, mix_norm, w_in,
              gla_alpha_w2, gla_alpha_b, gla_norm, rwkv_mu, rwkv_w0, rwkv_w2, rwkv_a0,
              rwkv_a2, rwkv_g2, rwkv_k_k, rwkv_k_a, rwkv_r_k, rwkv_ln_w, rwkv_ln_b, w_out,
              ffn2_norm, ffn2_w_gate, ffn2_w_up, ffn2_w_down, final_norm):
    for l in range(DEPTH):
        x = x + MACARON_WEIGHT * _swiglu(_rms_norm(x, ffn1_norm[l]), ffn1_w_gate[l], ffn1_w_up[l], ffn1_w_down[l])
        h = _rms_norm(x, mix_norm[l])
        proj = h @ w_in[l]
        gla_p, rwkv_p = jnp.split(proj, [GLA_PROJ], axis=-1)
        q, k, v, g_out, a_lr = _split_cols(gla_p, GLA_COLS)
        o_gla = _gla_mixer(q, k, v, g_out, a_lr, gla_alpha_w2[l], gla_alpha_b[l], gla_norm[l])
        o_rwkv = _rwkv7_mixer(rwkv_p, rwkv_mu[l], rwkv_w0[l], rwkv_w2[l], rwkv_a0[l], rwkv_a2[l],
                              rwkv_g2[l], rwkv_k_k[l], rwkv_k_a[l], rwkv_r_k[l], rwkv_ln_w[l], rwkv_ln_b[l])
        mixed = jnp.concatenate([o_gla, o_rwkv], axis=-1).astype(x.dtype)
        x = x + mixed @ w_out[l]
        x = x + MACARON_WEIGHT * _swiglu(_rms_norm(x, ffn2_norm[l]), ffn2_w_gate[l], ffn2_w_up[l], ffn2_w_down[l])
    return _rms_norm(x, final_norm)
```

```cpp
#include <hip/hip_runtime.h>
#include <cstdio>
#include <cstdint>
namespace pg8 {
#define PG8_LAS __attribute__((address_space(3)))
typedef unsigned short bf16_t;
typedef short bf16x8 __attribute__((ext_vector_type(8)));
typedef float f32x4 __attribute__((ext_vector_type(4)));
typedef unsigned u32x4 __attribute__((ext_vector_type(4)));
constexpr int BM = 256, BK = 64, HALF = 128, HTB = HALF * BK * 2  , STAGE_BYTES = 8 * HTB, NXCD = 8, WGM = 8;

__host__ __device__ __forceinline__ int lds_byte(int r, int c) { const int st = (r >> 4) * 2 + (c >> 5), rr = r & 15, cc = c & 31, ob = rr * 64 + cc * 2; return st * 1024 + (ob ^ (((ob >> 9) & 1) << 5)); }
__host__ __device__ __forceinline__ void stage_rc(int b, int& R, int& C) { const int st = b / 1024, sb = b % 1024, swz = sb ^ (((sb >> 9) & 1) << 5); R = (st >> 1) * 16 + swz / 64; C = (st & 1) * 32 + (swz % 64) / 2; }
__host__ __device__ __forceinline__ int perm32(int rho) { const int n = rho >> 4, i = rho & 15; return 8 * (i >> 2) + 4 * n + (i & 3); }

struct Unit { int pm, pn; };
struct Gemm { const bf16_t* A; const bf16_t* Bt; int M, N, K; };

struct StaticOrder {
    int nM, nN, nwg, G, c;
    __host__ __device__ void init(int M, int N, int G_, int c_) { nM = M / BM; nN = N / BM; nwg = nM * nN; G = G_; c = c_; }
    __host__ __device__ bool next(int i, Unit& u) const {
        const long L = (long)i * G + c; if (L >= nwg) return false;
        int wgid = (int)L; { const int q = nwg / NXCD, r = nwg % NXCD, xcd = wgid % NXCD, off = wgid / NXCD; wgid = (xcd < r ? xcd * (q + 1) : r * (q + 1) + (xcd - r) * q) + off; }
        const int nig = WGM * nN, gid = wgid / nig, fm = gid * WGM, gsz = (nM - fm) < WGM ? (nM - fm) : WGM;
        u.pm = fm + ((wgid % nig) % gsz); u.pn = (wgid % nig) / gsz; return true;
    }
    __device__ __forceinline__ void a_ready(const Unit&) const {}
    __device__ __forceinline__ void done(const Unit&) const {}
};

__device__ __forceinline__ unsigned cvt_pk_bf16(float lo, float hi) { unsigned r; asm volatile("v_cvt_pk_bf16_f32 %0, %1, %2" : "=v"(r) : "v"(lo), "v"(hi)); return r; }
__device__ __forceinline__ float fsigmoid(float x) { return __builtin_amdgcn_rcpf(1.0f + __builtin_amdgcn_exp2f(-1.44269504f * x)); }
constexpr float RMS_EPS = 1e-6f;
__device__ __forceinline__ float row_rs(const float* ssp, int row, int fq) {
    const f32x4 p = *(const f32x4*)(ssp + (size_t)row * 16 + 4 * fq);
    float s = (p[0] + p[1]) + (p[2] + p[3]); s += __shfl_xor(s, 16); s += __shfl_xor(s, 32);
    return rsqrtf(s * (1.0f / 1024.0f) + RMS_EPS);
}
struct EpiGateUp {
    static constexpr bool PERM = true, AFTER_DRAIN = false;
    bf16_t* H; const float* ssp; int ldh;
    __device__ __forceinline__ void operator()(const f32x4 (&acc)[2][2][4][2], const Unit& u, int wr, int wc, int fr, int fq) const {
        const int row0 = u.pm * BM + wr * 64 + fr, col0 = u.pn * HALF + wc * 32 + 8 * fq;
#pragma unroll
        for (int ai = 0; ai < 2; ++ai)
#pragma unroll
            for (int m = 0; m < 4; ++m) { const int row = row0 + ai * HALF + m * 16; const float rs = row_rs(ssp, row, fq);
                const f32x4 g0 = acc[ai][0][m][0] * rs, g1 = acc[ai][0][m][1] * rs, u0 = acc[ai][1][m][0] * rs, u1 = acc[ai][1][m][1] * rs;
                float h[8];
#pragma unroll
                for (int e = 0; e < 4; ++e) { h[e] = g0[e] * fsigmoid(g0[e]) * u0[e]; h[4 + e] = g1[e] * fsigmoid(g1[e]) * u1[e]; }
                u32x4 w; w.x = cvt_pk_bf16(h[0], h[1]); w.y = cvt_pk_bf16(h[2], h[3]); w.z = cvt_pk_bf16(h[4], h[5]); w.w = cvt_pk_bf16(h[6], h[7]);
                *(u32x4*)(H + (size_t)row * ldh + col0) = w;
                if (m & 1) asm volatile("" ::: "memory"); }
    }
};
struct EpiResid {
    static constexpr bool PERM = true, AFTER_DRAIN = false;
    const float* res; float* out; bf16_t* xb; float* ssp_out; float w;
    __device__ __forceinline__ void operator()(const f32x4 (&acc)[2][2][4][2], const Unit& u, int wr, int wc, int fr, int fq) const {
        const int row0 = u.pm * BM + wr * 64 + fr, col0 = u.pn * BM + wc * 32 + 8 * fq;
#pragma unroll
        for (int ai = 0; ai < 2; ++ai)
#pragma unroll
            for (int m = 0; m < 4; ++m) { const int row = row0 + ai * HALF + m * 16; const size_t off = (size_t)row * 1024 + col0; float ssq = 0.f;
#pragma unroll
                for (int bj = 0; bj < 2; ++bj) {
                    const f32x4 r0 = *(const f32x4*)(res + off + bj * HALF), r1 = *(const f32x4*)(res + off + bj * HALF + 4);
                    const f32x4 x0 = r0 + acc[ai][bj][m][0] * w, x1 = r1 + acc[ai][bj][m][1] * w;
                    *(f32x4*)(out + off + bj * HALF) = x0; *(f32x4*)(out + off + bj * HALF + 4) = x1;
                    ssq += (x0[0] * x0[0] + x0[1] * x0[1]) + (x0[2] * x0[2] + x0[3] * x0[3]) + (x1[0] * x1[0] + x1[1] * x1[1]) + (x1[2] * x1[2] + x1[3] * x1[3]);
                    if (xb) { u32x4 v; v.x = cvt_pk_bf16(x0[0], x0[1]); v.y = cvt_pk_bf16(x0[2], x0[3]); v.z = cvt_pk_bf16(x1[0], x1[1]); v.w = cvt_pk_bf16(x1[2], x1[3]); *(u32x4*)(xb + off + bj * HALF) = v; }
                }
                ssq += __shfl_xor(ssq, 16); ssq += __shfl_xor(ssq, 32);
                if (fq == 0) ssp_out[(size_t)row * 16 + u.pn * 4 + wc] = ssq;
                if (m & 1) asm volatile("" ::: "memory"); }
    }
};
struct EpiRowScale {
    static constexpr bool PERM = true, AFTER_DRAIN = false;
    bf16_t* P; const float* ssp; int ldp;
    __device__ __forceinline__ void operator()(const f32x4 (&acc)[2][2][4][2], const Unit& u, int wr, int wc, int fr, int fq) const {
        const int row0 = u.pm * BM + wr * 64 + fr, col0 = u.pn * BM + wc * 32 + 8 * fq;
#pragma unroll
        for (int ai = 0; ai < 2; ++ai)
#pragma unroll
            for (int m = 0; m < 4; ++m) { const int row = row0 + ai * HALF + m * 16; const float rs = row_rs(ssp, row, fq);
#pragma unroll
                for (int bj = 0; bj < 2; ++bj) { const f32x4 v0 = acc[ai][bj][m][0] * rs, v1 = acc[ai][bj][m][1] * rs;
                    u32x4 w; w.x = cvt_pk_bf16(v0[0], v0[1]); w.y = cvt_pk_bf16(v0[2], v0[3]); w.z = cvt_pk_bf16(v1[0], v1[1]); w.w = cvt_pk_bf16(v1[2], v1[3]);
                    *(u32x4*)(P + (size_t)row * ldp + col0 + bj * HALF) = w; }
                if (m & 1) asm volatile("" ::: "memory"); }
    }
};
template <class Epi, class Sched, bool ALIGN_EPI = false, bool SP2 = false>
__device__ __forceinline__ void gemm_phase(PG8_LAS unsigned char* lds, const Gemm g, const Sched& S, const Epi& E) {
    const int tid = threadIdx.x, wid = __builtin_amdgcn_readfirstlane(tid >> 6), lane = tid & 63, wr = wid >> 2, wc = wid & 3, fr = lane & 15, fq = lane >> 4;
    const int K = g.K, nt = K / BK;
    unsigned voffA[2], voffB[2];
#pragma unroll
    for (int i = 0; i < 2; ++i) { int R, C; stage_rc(tid * 16 + i * 8192, R, C); const int Rb = Epi::PERM ? ((R & ~31) + perm32(R & 31)) : R;
        voffA[i] = (unsigned)(R * K + C) * 2u; voffB[i] = (unsigned)(Rb * K + C) * 2u; }
    const size_t kstep = (size_t)(BK * 2);
    const size_t hstep = (size_t)HALF * K * 2;
    const size_t tstep = 2 * hstep;
    const unsigned ldsw = (unsigned)wid * 1024u;
    const int aoff = lds_byte(wr * 64 + fr, fq * 8), boff = lds_byte(wc * 32 + fr, fq * 8);
#define PG8_SA(b, h) (((b) * 2 + (h)) * HTB)
#define PG8_SB(b, h) ((4 + (b) * 2 + (h)) * HTB)
#define PG8_STAGE(bufoff, gbase, voff) do { _Pragma("unroll") for (int _i = 0; _i < 2; ++_i) \
        __builtin_amdgcn_global_load_lds((const unsigned*)((const char*)(gbase) + (voff)[_i]), (PG8_LAS unsigned*)(lds + (bufoff) + ldsw + _i * 8192), 16, 0, 0); } while (0)
#define PG8_LDA(dst, b, h) do { _Pragma("unroll") for (int m = 0; m < 4; ++m) _Pragma("unroll") for (int k = 0; k < 2; ++k) dst[m][k] = *(const PG8_LAS bf16x8*)(lds + PG8_SA(b, h) + aoff + m * 2048 + k * 1024); } while (0)
#define PG8_LDB(dst, b, h) do { _Pragma("unroll") for (int n = 0; n < 2; ++n) _Pragma("unroll") for (int k = 0; k < 2; ++k) dst[n][k] = *(const PG8_LAS bf16x8*)(lds + PG8_SB(b, h) + boff + n * 2048 + k * 1024); } while (0)
#define PG8_MMA(ai, bj, At, Bt) do { __builtin_amdgcn_s_setprio(1); _Pragma("unroll") for (int m = 0; m < 4; ++m) _Pragma("unroll") for (int n = 0; n < 2; ++n) _Pragma("unroll") for (int k = 0; k < 2; ++k) \
        acc[ai][bj][m][n] = __builtin_amdgcn_mfma_f32_16x16x32_bf16(Bt[n][k], At[m][k], acc[ai][bj][m][n], 0, 0, 0); __builtin_amdgcn_s_setprio(0); } while (0)
#define PG8_WAIT_V(n) asm volatile("s_waitcnt vmcnt(" #n ")" ::: "memory")
#define PG8_WAIT_L(n) asm volatile("s_waitcnt lgkmcnt(" #n ")" ::: "memory")
#define PG8_BAR __builtin_amdgcn_s_barrier()
#define PG8_SCHED __builtin_amdgcn_sched_barrier(0)
    Unit cur, nxt; int ui = 0;
    if (!S.next(0, cur)) return;
    f32x4 acc[2][2][4][2];
#pragma unroll
    for (int a = 0; a < 2; ++a)
#pragma unroll
        for (int b = 0; b < 2; ++b)
#pragma unroll
            for (int m = 0; m < 4; ++m)
#pragma unroll
                for (int n = 0; n < 2; ++n) acc[a][b][m][n] = (f32x4){0.f, 0.f, 0.f, 0.f};
    bf16x8 At[4][2], B0[2][2], B1[2][2];
    const char* cA = (const char*)g.A + (size_t)cur.pm * tstep; const char* cB = (const char*)g.Bt + (size_t)cur.pn * tstep;
    S.a_ready(cur);
    if constexpr (SP2) {
        PG8_STAGE(PG8_SB(0, 0), cB, voffB); PG8_STAGE(PG8_SB(0, 1), cB + hstep, voffB); PG8_STAGE(PG8_SA(0, 0), cA, voffA); PG8_STAGE(PG8_SA(0, 1), cA + hstep, voffA);
        if (wr == 1) PG8_BAR;
        PG8_WAIT_V(2); PG8_BAR;
        PG8_STAGE(PG8_SB(1, 0), cB + kstep, voffB); PG8_STAGE(PG8_SA(1, 0), cA + kstep, voffA); PG8_STAGE(PG8_SB(1, 1), cB + hstep + kstep, voffB);
        PG8_WAIT_V(6); PG8_BAR;
    } else {
        PG8_STAGE(PG8_SB(0, 0), cB, voffB); PG8_STAGE(PG8_SA(0, 0), cA, voffA); PG8_STAGE(PG8_SB(0, 1), cB + hstep, voffB); PG8_STAGE(PG8_SA(0, 1), cA + hstep, voffA);
        if (wr == 1) PG8_BAR;
        PG8_WAIT_V(4); PG8_BAR;
        PG8_STAGE(PG8_SB(1, 0), cB + kstep, voffB); PG8_STAGE(PG8_SA(1, 0), cA + kstep, voffA); PG8_STAGE(PG8_SB(1, 1), cB + hstep + kstep, voffB);
        PG8_WAIT_V(6); PG8_BAR;
    }
    for (;;) {
        const bool has_next = S.next(ui + 1, nxt);
        const char* nA = has_next ? (const char*)g.A + (size_t)nxt.pm * tstep : cA; const char* nB = has_next ? (const char*)g.Bt + (size_t)nxt.pn * tstep : cB;
        for (int t = 0; t < nt; t += 2) {
            const bool last = (t == nt - 2);
            const char* a1 = cA + (size_t)(t + 1) * kstep;
            const char* a2 = last ? nA : cA + (size_t)(t + 2) * kstep; const char* b2 = last ? nB : cB + (size_t)(t + 2) * kstep;
            const char* a3 = a2 + kstep; const char* b3 = b2 + kstep;
            if (last && has_next) S.a_ready(nxt);
            if constexpr (SP2) {
            PG8_LDB(B0, 0, 0); PG8_LDB(B1, 0, 1); PG8_SCHED; PG8_LDA(At, 0, 0); PG8_STAGE(PG8_SA(1, 1), a1 + hstep, voffA);
            PG8_WAIT_V(8); PG8_WAIT_L(0); PG8_BAR; PG8_MMA(0, 0, At, B0); PG8_MMA(0, 1, At, B1); PG8_BAR; PG8_SCHED;
            PG8_LDA(At, 0, 1); PG8_STAGE(PG8_SB(0, 0), b2, voffB); PG8_STAGE(PG8_SB(0, 1), b2 + hstep, voffB); PG8_STAGE(PG8_SA(0, 0), a2, voffA);
            PG8_WAIT_V(8); PG8_WAIT_L(0); PG8_BAR; PG8_MMA(1, 0, At, B0); PG8_MMA(1, 1, At, B1); PG8_BAR; PG8_SCHED;
            PG8_LDB(B0, 1, 0); PG8_LDB(B1, 1, 1); PG8_SCHED; PG8_LDA(At, 1, 0); PG8_STAGE(PG8_SA(0, 1), a2 + hstep, voffA);
            PG8_WAIT_V(8); PG8_WAIT_L(0); PG8_BAR; PG8_MMA(0, 0, At, B0); PG8_MMA(0, 1, At, B1); PG8_BAR; PG8_SCHED;
            PG8_LDA(At, 1, 1); PG8_STAGE(PG8_SB(1, 0), b3, voffB); PG8_STAGE(PG8_SB(1, 1), b3 + hstep, voffB); PG8_STAGE(PG8_SA(1, 0), a3, voffA);
            PG8_WAIT_V(8); PG8_WAIT_L(0); PG8_BAR; PG8_MMA(1, 0, At, B0); PG8_MMA(1, 1, At, B1); PG8_BAR; PG8_SCHED;
            } else {
            PG8_LDB(B0, 0, 0); PG8_SCHED; PG8_LDA(At, 0, 0); PG8_STAGE(PG8_SA(1, 1), a1 + hstep, voffA);
            PG8_WAIT_L(8); PG8_BAR; PG8_WAIT_L(0); PG8_MMA(0, 0, At, B0); PG8_BAR; PG8_SCHED;
            PG8_LDB(B1, 0, 1); PG8_STAGE(PG8_SB(0, 0), b2, voffB);
            PG8_BAR; PG8_WAIT_L(0); PG8_MMA(0, 1, At, B1); PG8_BAR;
            PG8_LDA(At, 0, 1); PG8_STAGE(PG8_SA(0, 0), a2, voffA);
            PG8_BAR; PG8_WAIT_L(0); PG8_MMA(1, 0, At, B0); PG8_BAR; PG8_SCHED;
            PG8_STAGE(PG8_SB(0, 1), b2 + hstep, voffB);
            PG8_WAIT_V(6); PG8_BAR; PG8_MMA(1, 1, At, B1); PG8_BAR;
            PG8_LDB(B0, 1, 0); PG8_SCHED; PG8_LDA(At, 1, 0); PG8_STAGE(PG8_SA(0, 1), a2 + hstep, voffA);
            PG8_WAIT_L(8); PG8_BAR; PG8_WAIT_L(0); PG8_MMA(0, 0, At, B0); PG8_BAR; PG8_SCHED;
            PG8_LDB(B1, 1, 1); PG8_STAGE(PG8_SB(1, 0), b3, voffB);
            PG8_BAR; PG8_WAIT_L(0); PG8_MMA(0, 1, At, B1); PG8_BAR;
            PG8_LDA(At, 1, 1); PG8_STAGE(PG8_SA(1, 0), a3, voffA);
            PG8_BAR; PG8_WAIT_L(0); PG8_MMA(1, 0, At, B0); PG8_BAR; PG8_SCHED;
            PG8_STAGE(PG8_SB(1, 1), b3 + hstep, voffB);
            PG8_WAIT_V(6); PG8_BAR; PG8_MMA(1, 1, At, B1); PG8_BAR;
            }
        }
        if constexpr (ALIGN_EPI) { if (wr == 0) PG8_BAR; }
        if constexpr (!Epi::AFTER_DRAIN) { E(acc, cur, wr, wc, fr, fq); S.done(cur); }
        if (!has_next) break;
#pragma unroll
        for (int a = 0; a < 2; ++a)
#pragma unroll
            for (int b = 0; b < 2; ++b)
#pragma unroll
                for (int m = 0; m < 4; ++m)
#pragma unroll
                    for (int n = 0; n < 2; ++n) acc[a][b][m][n] = (f32x4){0.f, 0.f, 0.f, 0.f};
        cur = nxt; cA = nA; cB = nB; ++ui;
        if constexpr (ALIGN_EPI) { if (wr == 1) PG8_BAR; }
    }
    PG8_WAIT_V(0);
    if constexpr (!ALIGN_EPI) { if (wr == 0) PG8_BAR; }
    PG8_BAR;
    if constexpr (Epi::AFTER_DRAIN) { E.fused(acc, cur, wr, wc, fr, fq, lds, wid, lane); S.done(cur); }
#undef PG8_SA
#undef PG8_SB
#undef PG8_STAGE
#undef PG8_LDA
#undef PG8_LDB
#undef PG8_MMA
#undef PG8_WAIT_V
#undef PG8_WAIT_L
#undef PG8_BAR
#undef PG8_SCHED
}
}

#ifndef PG8_SP2
#define PG8_SP2 true
#endif
#ifndef PG8_ALIGN
#define PG8_ALIGN true
#endif
#define GAS __attribute__((address_space(1)))
#define LAS __attribute__((address_space(3)))
typedef unsigned short bf16;
typedef unsigned v4u __attribute__((ext_vector_type(4)));
typedef float f32x4 __attribute__((ext_vector_type(4)));
typedef short bf16x8 __attribute__((ext_vector_type(8)));
typedef GAS unsigned gu32;
typedef GAS unsigned long long gu64;
#define RLX_AGENT __ATOMIC_RELAXED, __HIP_MEMORY_SCOPE_AGENT
#define LDS_WAIT() asm volatile("s_waitcnt lgkmcnt(0)" ::: "memory")
#define VM_WAIT() asm volatile("s_waitcnt vmcnt(0)" ::: "memory")
__device__ __forceinline__ unsigned long long rt() { return __builtin_amdgcn_s_memrealtime(); }
__device__ __forceinline__ unsigned f2bf(float f) { unsigned u = __builtin_bit_cast(unsigned, f); return (u + 0x7fffu + ((u >> 16) & 1u)) >> 16; }
__device__ __forceinline__ unsigned pk2(float lo, float hi) { return f2bf(lo) | (f2bf(hi) << 16); }

#define XB_TMO      128
#define XB_XCNT(j)  (256  + 64 * (j))
#define XB_XSUB(j)  (1280 + 64 * (j))
#define XB_XGEN(j)  (2304 + 64 * (j))
#define XB_TOP      3328
#define XB_TOPGEN   3392
#define XCD_BAR_WORDS 3456
#define XB_SPIN_CAP (1u << 18)

__device__ __forceinline__ unsigned xb_ld(unsigned* p)              { return __hip_atomic_load(p, __ATOMIC_RELAXED, __HIP_MEMORY_SCOPE_AGENT); }
__device__ __forceinline__ unsigned xb_add(unsigned* p, unsigned v) { return __hip_atomic_fetch_add(p, v, __ATOMIC_RELAXED, __HIP_MEMORY_SCOPE_AGENT); }
__device__ __forceinline__ unsigned xb_xcc_id() { return (unsigned)__builtin_amdgcn_s_getreg((3 << 11) | 20) & 0xFu; }
#define XB_SPIN(cond, bar) do { unsigned _sp = 0; while (cond) { __builtin_amdgcn_s_sleep(1); \
    if ((++_sp & 255u) == 0u) { if (xb_ld(&(bar)[XB_TMO])) break; if (_sp > XB_SPIN_CAP) { atomicAdd(&(bar)[XB_TMO], 1u); break; } } } } while (0)

struct XcdBarrier {
    unsigned* bar; unsigned x;
    volatile LAS unsigned* st;
};

__device__ __forceinline__ XcdBarrier xcd_barrier_post(unsigned* bar, volatile LAS unsigned* st) {
    XcdBarrier b; b.bar = bar; b.x = xb_xcc_id(); b.st = st;
    if (threadIdx.x == 0) (void)xb_add(&bar[XB_XCNT(b.x)], 1u);
    return b;
}
__device__ __forceinline__ void xcd_barrier_complete(unsigned* bar, unsigned x, unsigned& nloc, unsigned& nx) {
    const unsigned G = gridDim.x * gridDim.y * gridDim.z;
    unsigned sum, cnt, mine, sp = 0u;
    for (;;) {
        sum = 0u; cnt = 0u; mine = 0u;
#pragma unroll
        for (unsigned j = 0; j < 16; ++j) { const unsigned c = xb_ld(&bar[XB_XCNT(j)]); sum += c; cnt += (c > 0u) ? 1u : 0u; mine = (j == x) ? c : mine; }
        if (sum == G) break;
        __builtin_amdgcn_s_sleep(1);
        if ((++sp & 255u) == 0u) { if (xb_ld(&bar[XB_TMO])) break; if (sp > XB_SPIN_CAP) { atomicAdd(&bar[XB_TMO], 1u); break; } }
    }
    nloc = mine > 0u ? mine : 1u; nx = cnt > 0u ? cnt : 1u;
}

__device__ __forceinline__ void xcd_barrier(const XcdBarrier& b) {
    asm volatile("s_waitcnt vmcnt(0)" ::: "memory");
    __syncthreads();
    if (threadIdx.x == 0) {
        unsigned* bar = b.bar;
        __builtin_amdgcn_s_waitcnt(0);
        unsigned nloc = b.st[0], nx = b.st[1];
        if (nloc == 0u) { xcd_barrier_complete(bar, b.x, nloc, nx); b.st[0] = nloc; b.st[1] = nx; }
        const unsigned old = xb_add(&bar[XB_XSUB(b.x)], 1u);
        const unsigned gen = old / nloc;
        if (old + 1u == (gen + 1u) * nloc) {
            __builtin_amdgcn_fence(__ATOMIC_RELEASE, "agent");
            asm volatile("s_waitcnt vmcnt(0)" ::: "memory");
            const unsigned og = xb_add(&bar[XB_TOP], 1u);
            const unsigned tg = og / nx;
            if (og + 1u == (tg + 1u) * nx) xb_add(&bar[XB_TOPGEN], 1u);
            else XB_SPIN(xb_ld(&bar[XB_TOPGEN]) == tg, bar);
            __builtin_amdgcn_fence(__ATOMIC_ACQUIRE, "agent");
            xb_add(&bar[XB_XGEN(b.x)], 1u);
            asm volatile("s_waitcnt vmcnt(0)" ::: "memory");
        } else {
            XB_SPIN(xb_ld(&bar[XB_XGEN(b.x)]) == gen, bar);
            __builtin_amdgcn_fence(__ATOMIC_ACQUIRE, "agent");
            asm volatile("s_waitcnt vmcnt(0)" ::: "memory");
        }
    }
    __syncthreads();
}

constexpr int NWAVES = 8;
constexpr int BATCH = 8, SEQ = 8192, D = 1024, FF = 2816;
constexpr int M = BATCH * SEQ;
constexpr int NGU = 2 * FF;
constexpr int PW = 3584;
constexpr int PROJ_ORIG = 3344;
constexpr int RB = 1600, GLA_ORIG_W = 1552;
constexpr int NLORA = 1536, KLORA = 256;
constexpr int NIN = 27;
constexpr size_t MiB = 1u << 20;
constexpr size_t WS_CTL = 0, CTL_ZERO_BYTES = 1 * MiB;
constexpr size_t WS_WGU1 = 2 * MiB, WS_WD1 = 14 * MiB, WS_WIN = 20 * MiB, WS_WOUT = 28 * MiB, WS_WGU2 = 30 * MiB, WS_WD2 = 42 * MiB, WS_WLORA = 48 * MiB;
constexpr size_t WS_SSP0 = 50 * MiB, WS_SSP1 = 54 * MiB, WS_SSP2 = 58 * MiB, WS_SSP3 = 62 * MiB;
constexpr size_t WS_XB = 68 * MiB;
constexpr size_t WS_Y = WS_XB;
constexpr size_t WS_HP = 196 * MiB;
constexpr size_t WS_MIXED = 644 * MiB;
constexpr size_t WS_LORA = 772 * MiB;
constexpr size_t WS_ALORA = 964 * MiB;
constexpr size_t WS_END = 996 * MiB;
constexpr int CW_BAR = 4096;
constexpr int RING_OFF = 0, RING_BYTES = 131072;
constexpr int LDSCTL_OFF = RING_BYTES, MISC_OFF = LDSCTL_OFF + 320;
constexpr int LDS_BYTES = 147456;

struct Frame {
    LAS unsigned char* lds;
    volatile LAS unsigned* MISC;
    gu32* ctl;
    int tid, lane, wave;
    int vcu, G;
};
__device__ __forceinline__ float wave_sum(float v) {
#pragma unroll
    for (int o = 1; o < 64; o <<= 1) v += __shfl_xor(v, o);
    return v;
}
template <int MAP> __device__ __forceinline__ int rowmap(int n) {
    if (MAP == 1) return ((n >> 7) << 8) + (n & 127);
    if (MAP == 2) return ((n >> 7) << 8) + 128 + (n & 127);
    if (MAP == 3) return n < GLA_ORIG_W ? n : n + (RB - GLA_ORIG_W);
    return n;
}
template <int MAP> __device__ __forceinline__ void p0_item(const float* W, const float* gain, int K, int N, bf16* WT, LAS float* scr, int item, int lane) {
    const int nblk = (N + 31) / 32, kb = item / nblk, nb = item % nblk, k0 = 64 * kb, n0 = 32 * nb;
    const int nn = n0 + (lane & 31);
#pragma unroll 8
    for (int i = 0; i < 32; ++i) { const int kk = 2 * i + (lane >> 5); float v = 0.f; if (nn < N) v = W[(size_t)(k0 + kk) * N + nn]; if (gain) v *= gain[k0 + kk]; scr[kk * 33 + (lane & 31)] = v; }
    LDS_WAIT(); asm volatile("" ::: "memory");
    const int c = lane & 7;
#pragma unroll
    for (int j = 0; j < 4; ++j) { const int nl = (lane >> 3) + 8 * j; const LAS float* s = scr + (8 * c) * 33 + nl;
        v4u o; o.x = pk2(s[0 * 33], s[1 * 33]); o.y = pk2(s[2 * 33], s[3 * 33]); o.z = pk2(s[4 * 33], s[5 * 33]); o.w = pk2(s[6 * 33], s[7 * 33]);
        if (n0 + nl < N) *(GAS v4u*)(WT + (size_t)rowmap<MAP>(n0 + nl) * K + k0 + 8 * c) = o; }
    LDS_WAIT(); asm volatile("" ::: "memory");
}
struct Args { const float* in[NIN]; float* out; unsigned char* ws; int ph_lo, ph_hi; };
static_assert(sizeof(Args) == NIN * 8 + 8 + 8 + 8, "Args has no padding");

__device__ __forceinline__ void p0_prologue(Frame& F, const Args& a) {
    LAS float* scr = (LAS float*)(F.lds + RING_OFF + F.wave * 16384);
    const int gw = F.vcu * NWAVES + F.wave, NGW = F.G * NWAVES;
    unsigned char* ws = a.ws;
    constexpr int I_GU = (D / 64) * (FF / 32), I_DN = (FF / 64) * (D / 32), I_IN = (D / 64) * ((PROJ_ORIG + 31) / 32), I_OUT = (D / 64) * (D / 32);
    constexpr int NITEMS = 2 * (2 * I_GU + I_DN) + I_IN + I_OUT;
    for (int it = gw; it < NITEMS; it += NGW) {
        int r = it;
        if (r < I_GU) { p0_item<1>(a.in[2], a.in[1], D, FF, (bf16*)(ws + WS_WGU1), scr, r, F.lane); continue; } r -= I_GU;
        if (r < I_GU) { p0_item<2>(a.in[3], a.in[1], D, FF, (bf16*)(ws + WS_WGU1), scr, r, F.lane); continue; } r -= I_GU;
        if (r < I_DN) { p0_item<0>(a.in[4], nullptr, FF, D, (bf16*)(ws + WS_WD1), scr, r, F.lane); continue; } r -= I_DN;
        if (r < I_GU) { p0_item<1>(a.in[23], a.in[22], D, FF, (bf16*)(ws + WS_WGU2), scr, r, F.lane); continue; } r -= I_GU;
        if (r < I_GU) { p0_item<2>(a.in[24], a.in[22], D, FF, (bf16*)(ws + WS_WGU2), scr, r, F.lane); continue; } r -= I_GU;
        if (r < I_DN) { p0_item<0>(a.in[25], nullptr, FF, D, (bf16*)(ws + WS_WD2), scr, r, F.lane); continue; } r -= I_DN;
        if (r < I_IN) { p0_item<3>(a.in[6], a.in[5], D, PROJ_ORIG, (bf16*)(ws + WS_WIN), scr, r, F.lane); continue; } r -= I_IN;
        p0_item<0>(a.in[21], nullptr, D, D, (bf16*)(ws + WS_WOUT), scr, r, F.lane);
    }
    const float* x = a.in[0]; bf16* xb = (bf16*)(ws + WS_XB); float* ssp = (float*)(ws + WS_SSP0);
    for (int m = gw; m < M; m += NGW) {
        const GAS f32x4* xr = (const GAS f32x4*)(x + (size_t)m * D) + F.lane;
        f32x4 v[4]; float s = 0.f;
#pragma unroll
        for (int j = 0; j < 4; ++j) { v[j] = xr[64 * j]; s += (v[j].x * v[j].x + v[j].y * v[j].y) + (v[j].z * v[j].z + v[j].w * v[j].w); }
        s = wave_sum(s);
        GAS unsigned long long* o8 = (GAS unsigned long long*)(xb + (size_t)m * D) + F.lane;
#pragma unroll
        for (int j = 0; j < 4; ++j) o8[64 * j] = (unsigned long long)pk2(v[j].x, v[j].y) | ((unsigned long long)pk2(v[j].z, v[j].w) << 32);
        if (F.lane < 16) ssp[(size_t)m * 16 + F.lane] = (F.lane == 0) ? s : 0.f;
    }
}
__device__ __forceinline__ void final_norm(Frame& F, const Args& a) {
    const int gw = F.vcu * NWAVES + F.wave, NGW = F.G * NWAVES;
    const float* ssp = (const float*)(a.ws + WS_SSP3); const float* g = a.in[26];
    f32x4 gv[4];
#pragma unroll
    for (int j = 0; j < 4; ++j) gv[j] = ((const GAS f32x4*)g)[F.lane + 64 * j];
    for (int m = gw; m < M; m += NGW) {
        float s = ssp[(size_t)m * 16 + (F.lane & 15)];
        s += __shfl_xor(s, 1); s += __shfl_xor(s, 2); s += __shfl_xor(s, 4); s += __shfl_xor(s, 8);
        const float rs = rsqrtf(s * (1.0f / 1024.0f) + 1e-6f);
        GAS f32x4* xr = (GAS f32x4*)(a.out + (size_t)m * D) + F.lane;
#pragma unroll
        for (int j = 0; j < 4; ++j) { f32x4 v = xr[64 * j]; v = v * rs * gv[j]; xr[64 * j] = v; }
    }
}

__global__ void __launch_bounds__(NWAVES * 64, 2) skel_fwd(Args args) {
    extern __shared__ __attribute__((aligned(16))) unsigned char lds[];
    Frame F;
    F.lds = (LAS unsigned char*)lds;
    F.MISC = (volatile LAS unsigned*)(F.lds + MISC_OFF);
    F.tid = threadIdx.x; F.lane = F.tid & 63; F.wave = __builtin_amdgcn_readfirstlane(F.tid >> 6);
    F.G = gridDim.x; { const int bx = blockIdx.x; F.vcu = (F.G % 8 == 0) ? (bx % 8) * (F.G / 8) + bx / 8 : bx; }
    unsigned char* ws = args.ws;
    F.ctl = (gu32*)(ws + WS_CTL);
    for (int u = F.tid; u < (LDS_BYTES - LDSCTL_OFF) / 4; u += NWAVES * 64) ((LAS unsigned*)(F.lds + LDSCTL_OFF))[u] = 0u;
    __syncthreads();
    const int lo = args.ph_lo, hi = args.ph_hi;
    XcdBarrier bar; bar.bar = (unsigned*)(F.ctl + CW_BAR); bar.x = 0; bar.st = nullptr;
    if (hi - lo > 1) bar = xcd_barrier_post((unsigned*)(F.ctl + CW_BAR), F.MISC + 8);
#define IN(k) (lo <= (k) && (k) < hi)
#define BOTH(k) (IN(k) && (k) + 1 < hi)
#define GRID_BAR() xcd_barrier(bar)
    bf16* const XB = (bf16*)(ws + WS_XB); bf16* const HP = (bf16*)(ws + WS_HP); bf16* const MIXED = (bf16*)(ws + WS_MIXED);
    float* const SSP0 = (float*)(ws + WS_SSP0); float* const SSP1 = (float*)(ws + WS_SSP1); float* const SSP2 = (float*)(ws + WS_SSP2); float* const SSP3 = (float*)(ws + WS_SSP3);

    if (IN(0)) { p0_prologue(F, args); if (BOTH(0)) GRID_BAR(); }
    if (IN(1)) {
        pg8::Gemm g{XB, (const bf16*)(ws + WS_WGU1), M, NGU, D}; pg8::StaticOrder S; S.init(M, NGU, F.G, (int)blockIdx.x);
        pg8::EpiGateUp E{HP, SSP0, FF};
        pg8::gemm_phase<pg8::EpiGateUp, pg8::StaticOrder, PG8_ALIGN, PG8_SP2>(F.lds + RING_OFF, g, S, E);
        if (BOTH(1)) GRID_BAR();
    }
    if (IN(2)) {
        pg8::Gemm g{HP, (const bf16*)(ws + WS_WD1), M, D, FF}; pg8::StaticOrder S; S.init(M, D, F.G, (int)blockIdx.x);
        pg8::EpiResid E{args.in[0], args.out, XB, SSP1, 0.5f};
        pg8::gemm_phase<pg8::EpiResid, pg8::StaticOrder, PG8_ALIGN, PG8_SP2>(F.lds + RING_OFF, g, S, E);
        if (BOTH(2)) GRID_BAR();
    }
    if (IN(3)) {
        pg8::Gemm g{XB, (const bf16*)(ws + WS_WIN), M, PW, D}; pg8::StaticOrder S; S.init(M, PW, F.G, (int)blockIdx.x);
        pg8::EpiRowScale E{HP, SSP1, PW};
        pg8::gemm_phase<pg8::EpiRowScale, pg8::StaticOrder, PG8_ALIGN, PG8_SP2>(F.lds + RING_OFF, g, S, E);
        if (BOTH(3)) GRID_BAR();
    }
    if (IN(8)) {
        pg8::Gemm g{MIXED, (const bf16*)(ws + WS_WOUT), M, D, D}; pg8::StaticOrder S; S.init(M, D, F.G, (int)blockIdx.x);
        pg8::EpiResid E{args.out, args.out, XB, SSP2, 1.0f};
        pg8::gemm_phase<pg8::EpiResid, pg8::StaticOrder, PG8_ALIGN, PG8_SP2>(F.lds + RING_OFF, g, S, E);
        if (BOTH(8)) GRID_BAR();
    }
    if (IN(9)) {
        pg8::Gemm g{XB, (const bf16*)(ws + WS_WGU2), M, NGU, D}; pg8::StaticOrder S; S.init(M, NGU, F.G, (int)blockIdx.x);
        pg8::EpiGateUp E{HP, SSP2, FF};
        pg8::gemm_phase<pg8::EpiGateUp, pg8::StaticOrder, PG8_ALIGN, PG8_SP2>(F.lds + RING_OFF, g, S, E);
        if (BOTH(9)) GRID_BAR();
    }
    if (IN(10)) {
        pg8::Gemm g{HP, (const bf16*)(ws + WS_WD2), M, D, FF}; pg8::StaticOrder S; S.init(M, D, F.G, (int)blockIdx.x);
        pg8::EpiResid E{args.out, args.out, nullptr, SSP3, 0.5f};
        pg8::gemm_phase<pg8::EpiResid, pg8::StaticOrder, PG8_ALIGN, PG8_SP2>(F.lds + RING_OFF, g, S, E);
        if (BOTH(10)) GRID_BAR();
    }
    if (IN(11)) { final_norm(F, args); }
#undef IN
#undef BOTH
}

__device__ __forceinline__ float bf2f(bf16 v) { return __builtin_bit_cast(float, (unsigned)v << 16); }
__device__ __forceinline__ bf16 f2bf16(float f) { return (bf16)f2bf(f); }
__device__ __forceinline__ float sigmoidf_(float x) { return 1.0f / (1.0f + expf(-x)); }
__device__ __forceinline__ float logsigmoidf_(float x) { return fminf(x, 0.f) - log1pf(expf(-fabsf(x))); }

__global__ void __launch_bounds__(128) naive_gla(const bf16* __restrict__ proj, const float* __restrict__ aw2, const float* __restrict__ ab, const float* __restrict__ normw, bf16* __restrict__ mixed) {
    const int b = blockIdx.x >> 2, h = blockIdx.x & 3, v = threadIdx.x;
    __shared__ float sq[64], sk[64], sal[64], sred[2];
    float S[64];
#pragma unroll
    for (int d = 0; d < 64; ++d) S[d] = 0.f;
    const float nw = normw[v];
    for (int t = 0; t < SEQ; ++t) {
        const size_t row = (size_t)b * SEQ + t; const bf16* p = proj + row * PW;
        if (v < 64) { const int d = v;
            float logit = ab[h * 64 + d];
            for (int r = 0; r < 16; ++r) logit += bf2f(p[1536 + r]) * aw2[r * 256 + h * 64 + d];
            sal[d] = expf(logsigmoidf_(logit) * (1.0f / 16.0f)); sq[d] = bf2f(p[h * 64 + d]) * 0.125f; sk[d] = bf2f(p[256 + h * 64 + d]); }
        __syncthreads();
        const float vv = bf2f(p[512 + h * 128 + v]);
        float o = 0.f;
#pragma unroll
        for (int d = 0; d < 64; ++d) { S[d] = sal[d] * S[d] + sk[d] * vv; o += sq[d] * S[d]; }
        float ss = wave_sum(o * o);
        if ((v & 63) == 0) sred[v >> 6] = ss;
        __syncthreads();
        const float ms = (sred[0] + sred[1]) * (1.0f / 128.0f);
        const float gate = bf2f(p[1024 + h * 128 + v]);
        const float outv = o * rsqrtf(ms + 1e-6f) * nw * (gate * sigmoidf_(gate));
        mixed[row * D + h * 128 + v] = f2bf16(outv);
        __syncthreads();
    }
}
__global__ void __launch_bounds__(512) naive_lora(const bf16* __restrict__ proj, const float* __restrict__ mu, const float* __restrict__ w0, const float* __restrict__ w2, const float* __restrict__ a0,
                                                  const float* __restrict__ a2, const float* __restrict__ g2, bf16* __restrict__ lora) {
    const int m = blockIdx.x, t = m % SEQ, c = threadIdx.x;
    __shared__ float s_in[256];
    if (c < 256) { const bf16* p = proj + (size_t)m * PW + RB + 1536 + c; const float cur = bf2f(p[0]); const float prev = t > 0 ? bf2f(p[-PW]) : 0.f;
        const float ps = cur + mu[1536 + c] * (prev - cur);
        s_in[c] = c < 64 ? tanhf(ps) : (c < 128 ? ps : sigmoidf_(ps)); }
    __syncthreads();
    float wz = w0[c], az = a0[c], gz = 0.f;
#pragma unroll 4
    for (int i = 0; i < 64; ++i) { wz += s_in[i] * w2[i * 512 + c]; az += s_in[64 + i] * a2[i * 512 + c]; }
#pragma unroll 4
    for (int i = 0; i < 128; ++i) gz += s_in[128 + i] * g2[i * 512 + c];
    bf16* o = lora + (size_t)m * NLORA;
    o[c] = f2bf16(-0.60653066f * sigmoidf_(wz)); o[512 + c] = f2bf16(sigmoidf_(az)); o[1024 + c] = f2bf16(gz);
}
__global__ void __launch_bounds__(64) naive_rwkv(const bf16* __restrict__ proj, const bf16* __restrict__ lora, const float* __restrict__ mu, const float* __restrict__ k_k, const float* __restrict__ k_a,
                                                 const float* __restrict__ r_k, const float* __restrict__ ln_w, const float* __restrict__ ln_b, bf16* __restrict__ mixed) {
    const int b = blockIdx.x >> 3, h = blockIdx.x & 7, j = threadIdx.x, hc = h * 64;
    __shared__ float s_r[64], s_w[64], s_k[64], s_A[64], s_B[64];
    float S[64];
#pragma unroll
    for (int d = 0; d < 64; ++d) S[d] = 0.f;
    const float mur = mu[hc + j], muk = mu[512 + hc + j], muv = mu[1024 + hc + j], kkc = k_k[hc + j], kac = k_a[hc + j], rkc = r_k[hc + j], lw = ln_w[hc + j], lb = ln_b[hc + j];
    float pr = 0.f, pk = 0.f, pv = 0.f;
    for (int t = 0; t < SEQ; ++t) {
        const size_t row = (size_t)b * SEQ + t; const bf16* p = proj + row * PW + RB; const bf16* lo = lora + row * NLORA;
        const float cr = bf2f(p[hc + j]), ck = bf2f(p[512 + hc + j]), cv = bf2f(p[1024 + hc + j]);
        const float r = cr + mur * (pr - cr), k = ck + muk * (pk - ck), vv = cv + muv * (pv - cv);
        pr = cr; pk = ck; pv = cv;
        const float decay = expf(bf2f(lo[hc + j])), a = bf2f(lo[512 + hc + j]), g = bf2f(lo[1024 + hc + j]);
        float kk = k * kkc; const float nrm = sqrtf(wave_sum(kk * kk)); kk = kk / fmaxf(nrm, 1e-12f);
        const float kp = k * (1.0f + (a - 1.0f) * kac);
        const float bonus = wave_sum(r * kp * rkc);
        __syncthreads();
        s_r[j] = r; s_w[j] = decay; s_k[j] = kp; s_A[j] = -kk; s_B[j] = kk * a;
        __syncthreads();
        float sa = 0.f;
#pragma unroll
        for (int d = 0; d < 64; ++d) sa += S[d] * s_A[d];
        float y = 0.f;
#pragma unroll
        for (int d = 0; d < 64; ++d) { S[d] = S[d] * s_w[d] + sa * s_B[d] + vv * s_k[d]; y += S[d] * s_r[d]; }
        const float mean = wave_sum(y) * (1.0f / 64.0f); const float dv = y - mean; const float var = wave_sum(dv * dv) * (1.0f / 64.0f);
        const float yn = dv * rsqrtf(var + 64e-5f) * lw + lb;
        mixed[row * D + 512 + hc + j] = f2bf16((yn + bonus * vv) * g);
    }
}

static void launch_skel(int grid, hipStream_t stream, Args a, int lo, int hi) {
    a.ph_lo = lo; a.ph_hi = hi;
    hipLaunchKernelGGL(skel_fwd, dim3(grid), dim3(NWAVES * 64), LDS_BYTES, stream, a);
}
extern "C" void kernel_launch(void* const* d_in, const int* in_sizes, int n_in, void* d_out, int out_size, void* d_ws, size_t ws_size, hipStream_t stream) {
    static int grid = 0;
    if (grid == 0) {
        if (n_in != NIN || in_sizes[0] != M * D || out_size != M * D || ws_size < WS_END) { fprintf(stderr, "kernel_launch: unexpected shapes (n_in %d, in0 %d, out %d, ws %zu)\n", n_in, n_in > 0 ? in_sizes[0] : -1, out_size, ws_size); grid = -1; return; }
        int dev = 0, cus = 0;
        if (hipGetDevice(&dev) != hipSuccess || hipDeviceGetAttribute(&cus, hipDeviceAttributeMultiprocessorCount, dev) != hipSuccess) { grid = -1; return; }
        if (hipFuncSetAttribute((const void*)skel_fwd, hipFuncAttributeMaxDynamicSharedMemorySize, LDS_BYTES) != hipSuccess) { fprintf(stderr, "kernel_launch: hipFuncSetAttribute failed\n"); grid = -1; return; }
        (void)hipGetLastError();
        grid = cus;
    }
    if (grid < 0) return;
    if (hipMemsetAsync((char*)d_ws + WS_CTL, 0, CTL_ZERO_BYTES, stream) != hipSuccess) return;
    Args a{};
    for (int i = 0; i < NIN; ++i) a.in[i] = (const float*)d_in[i];
    a.out = (float*)d_out; a.ws = (unsigned char*)d_ws;
    unsigned char* ws = (unsigned char*)d_ws;
    launch_skel(grid, stream, a, 0, 1);
    launch_skel(grid, stream, a, 1, 2);
    launch_skel(grid, stream, a, 2, 3);
    launch_skel(grid, stream, a, 3, 4);
    const bf16* proj = (const bf16*)(ws + WS_HP); bf16* lora = (bf16*)(ws + WS_LORA); bf16* mixed = (bf16*)(ws + WS_MIXED);
    hipLaunchKernelGGL(naive_lora, dim3(M), dim3(512), 0, stream, proj, a.in[10], a.in[11], a.in[12], a.in[13], a.in[14], a.in[15], lora);
    hipLaunchKernelGGL(naive_gla, dim3(32), dim3(128), 0, stream, proj, a.in[7], a.in[8], a.in[9], mixed);
    hipLaunchKernelGGL(naive_rwkv, dim3(64), dim3(64), 0, stream, proj, (const bf16*)lora, a.in[10], a.in[16], a.in[17], a.in[18], a.in[19], a.in[20], mixed);
    launch_skel(grid, stream, a, 8, 9);
    launch_skel(grid, stream, a, 9, 10);
    launch_skel(grid, stream, a, 10, 11);
    launch_skel(grid, stream, a, 11, 12);
}
```

```cpp
#include <hip/hip_runtime.h>
#include <cstdio>
#include <cstdint>
__device__ __forceinline__ int lane_id_() { int l; asm volatile("v_mbcnt_lo_u32_b32 %0, -1, 0\n\tv_mbcnt_hi_u32_b32 %0, -1, %0" : "=v"(l)); return l; }
namespace pg8 {
#define PG8_LAS __attribute__((address_space(3)))
typedef unsigned short bf16_t;
typedef short bf16x8 __attribute__((ext_vector_type(8)));
typedef float f32x4 __attribute__((ext_vector_type(4)));
typedef unsigned u32x4 __attribute__((ext_vector_type(4)));
constexpr int BM = 256, BK = 64, HALF = 128, HTB = HALF * BK * 2  , STAGE_BYTES = 8 * HTB, NXCD = 8, WGM = 8;

__host__ __device__ __forceinline__ int lds_byte(int r, int c) { const int st = (r >> 4) * 2 + (c >> 5), rr = r & 15, cc = c & 31, ob = rr * 64 + cc * 2; return st * 1024 + (ob ^ (((ob >> 9) & 1) << 5)); }
__host__ __device__ __forceinline__ void stage_rc(int b, int& R, int& C) { const int st = b / 1024, sb = b % 1024, swz = sb ^ (((sb >> 9) & 1) << 5); R = (st >> 1) * 16 + swz / 64; C = (st & 1) * 32 + (swz % 64) / 2; }
__host__ __device__ __forceinline__ int perm32(int rho) { const int n = rho >> 4, i = rho & 15; return 8 * (i >> 2) + 4 * n + (i & 3); }

struct Unit { int pm, pn; };
struct Gemm { const bf16_t* A; const bf16_t* Bt; int M, N, K, ld; };

struct StaticOrder {
    int nM, nN, nwg, G, c, rev;
    __host__ __device__ void init(int M, int N, int G_, int c_, int rev_ = 0) { nM = M / BM; nN = N / BM; nwg = nM * nN; G = G_; c = c_; rev = rev_; }
    __host__ __device__ bool next(int i, Unit& u) const {
        const int L = i * G + c; if (L >= nwg) return false;
        int wgid = L; { const int q = nwg / NXCD, r = nwg % NXCD, xcd = wgid % NXCD, off = wgid / NXCD; wgid = (xcd < r ? xcd * (q + 1) : r * (q + 1) + (xcd - r) * q) + off; }
        const int nig = WGM * nN, gid = wgid / nig, fm = gid * WGM, gsz = (nM - fm) < WGM ? (nM - fm) : WGM;
        u.pm = fm + ((wgid % nig) % gsz); u.pn = (wgid % nig) / gsz; if (rev) u.pm = nM - 1 - u.pm; return true;
    }
    __device__ __forceinline__ void a_ready(const Unit&) const {}
    __device__ __forceinline__ void done(const Unit&) const {}
};

__device__ __forceinline__ unsigned cvt_pk_bf16(float lo, float hi) { unsigned r; asm volatile("v_cvt_pk_bf16_f32 %0, %1, %2" : "=v"(r) : "v"(lo), "v"(hi)); return r; }
__device__ __forceinline__ float fsigmoid(float x) { return __builtin_amdgcn_rcpf(1.0f + __builtin_amdgcn_exp2f(-1.44269504f * x)); }
constexpr float RMS_EPS = 1e-6f;
__device__ __forceinline__ float row_rs(const float* ssp, int row, int fq) {
    const f32x4 p = *(const f32x4*)(ssp + (size_t)row * 16 + 4 * fq);
    float s = (p[0] + p[1]) + (p[2] + p[3]); s += __shfl_xor(s, 16); s += __shfl_xor(s, 32);
    return rsqrtf(s * (1.0f / 1024.0f) + RMS_EPS);
}
__device__ __forceinline__ float row_rs_lds(const PG8_LAS unsigned char* aux, int lrow, int fq) {
    const f32x4 p = *(const PG8_LAS f32x4*)(aux + lrow * 64 + fq * 16);
    float s = (p[0] + p[1]) + (p[2] + p[3]); s += __shfl_xor(s, 16); s += __shfl_xor(s, 32);
    return rsqrtf(s * (1.0f / 1024.0f) + RMS_EPS);
}
__device__ __forceinline__ float row_ms_lds(const PG8_LAS unsigned char* aux, int lrow, int fq) {
    const f32x4 p = *(const PG8_LAS f32x4*)(aux + lrow * 64 + fq * 16);
    float s = (p[0] + p[1]) + (p[2] + p[3]); s += __shfl_xor(s, 16); s += __shfl_xor(s, 32);
    return s * (1.0f / 1024.0f) + RMS_EPS;
}
#define PG8_STAGE_AUX() __device__ __forceinline__ void stage_aux(const Unit& u, int wid, int lane) const { \
        const char* src = (const char*)(ssp + (size_t)u.pm * BM * 16) + wid * 1024 + lane * 16; \
        _Pragma("unroll") for (int i = 0; i < 2; ++i) __builtin_amdgcn_global_load_lds((const unsigned*)(src + i * 8192), (PG8_LAS unsigned*)(aux + wid * 1024 + i * 8192), 16, 0, 0); }
struct EpiGateUp {
    static constexpr bool PERM = true, AFTER_DRAIN = false, AUX = true; static constexpr int NST = 8;
    bf16_t* H; const float* ssp; int ldh; PG8_LAS unsigned char* aux;
    PG8_STAGE_AUX()
    __device__ __forceinline__ void operator()(const f32x4 (&acc)[2][2][4][2], const Unit& u, int wr, int wc, int fr, int fq) const {
        bf16_t* const Hb = H + ((size_t)(u.pm * (ldh / 64) + 2 * u.pn + (wc >> 1)) * BM + wr * 64 + fr) * 64 + (wc & 1) * 32 + 8 * fq;
#pragma unroll
        for (int ai = 0; ai < 2; ++ai) {
            float msv[4];
#pragma unroll
            for (int m = 0; m < 4; ++m) msv[m] = row_ms_lds(aux, wr * 64 + fr + ai * HALF + m * 16, fq);
#pragma unroll
            for (int m = 0; m < 4; ++m) { const float ms = msv[m], c1 = -1.44269504f * __builtin_amdgcn_rsqf(ms);
                float h[8];
#pragma unroll
                for (int n = 0; n < 2; ++n)
#pragma unroll
                    for (int e = 0; e < 4; ++e) { const float g = acc[ai][0][m][n][e], up = acc[ai][1][m][n][e];
                        const float d = __builtin_fmaf(__builtin_amdgcn_exp2f(g * c1), ms, ms);
                        h[4 * n + e] = (g * up) * __builtin_amdgcn_rcpf(d); }
                u32x4 w; w.x = cvt_pk_bf16(h[0], h[1]); w.y = cvt_pk_bf16(h[2], h[3]); w.z = cvt_pk_bf16(h[4], h[5]); w.w = cvt_pk_bf16(h[6], h[7]);
                *(u32x4*)(Hb + (ai * HALF + m * 16) * 64) = w;
                if (m & 1) asm volatile("" ::: "memory"); }
        }
    }
};
template <bool RES_BF16, bool OUT_F32> struct EpiResid {
    static constexpr bool PERM = true, AFTER_DRAIN = false, AUX = false; static constexpr int NST = 0;
    const float* res32; const bf16_t* res16; float* out32; bf16_t* xb; float* ssp_out; float w;
    __device__ __forceinline__ void finish(const f32x4& x0, const f32x4& x1, size_t off, float& ssq) const {
        if (OUT_F32) { *(f32x4*)(out32 + off) = x0; *(f32x4*)(out32 + off + 4) = x1; }
        ssq += (x0[0] * x0[0] + x0[1] * x0[1]) + (x0[2] * x0[2] + x0[3] * x0[3]) + (x1[0] * x1[0] + x1[1] * x1[1]) + (x1[2] * x1[2] + x1[3] * x1[3]);
        if constexpr (!OUT_F32) { u32x4 v; v.x = cvt_pk_bf16(x0[0], x0[1]); v.y = cvt_pk_bf16(x0[2], x0[3]); v.z = cvt_pk_bf16(x1[0], x1[1]); v.w = cvt_pk_bf16(x1[2], x1[3]); *(u32x4*)(xb + off) = v; }
    }
    __device__ __forceinline__ void operator()(const f32x4 (&acc)[2][2][4][2], const Unit& u, int wr, int wc, int fr, int fq) const {
        const int row0 = u.pm * BM + wr * 64 + fr, col0 = u.pn * BM + wc * 32 + 8 * fq;
        if constexpr (RES_BF16) {
            u32x4 rw[2][4][2];
#pragma unroll
            for (int ai = 0; ai < 2; ++ai)
#pragma unroll
                for (int m = 0; m < 4; ++m)
#pragma unroll
                    for (int bj = 0; bj < 2; ++bj) rw[ai][m][bj] = *(const u32x4*)(res16 + (size_t)(row0 + ai * HALF + m * 16) * 1024 + col0 + bj * HALF);
#pragma unroll
            for (int ai = 0; ai < 2; ++ai) {
                float sv = 0.f;
#pragma unroll
                for (int m = 0; m < 4; ++m) { const int row = row0 + ai * HALF + m * 16; const size_t off = (size_t)row * 1024 + col0; float ssq = 0.f;
#pragma unroll
                    for (int bj = 0; bj < 2; ++bj) { const u32x4 r = rw[ai][m][bj];
                        const f32x4 r0 = {__builtin_bit_cast(float, r.x << 16), __builtin_bit_cast(float, r.x & 0xffff0000u), __builtin_bit_cast(float, r.y << 16), __builtin_bit_cast(float, r.y & 0xffff0000u)};
                        const f32x4 r1 = {__builtin_bit_cast(float, r.z << 16), __builtin_bit_cast(float, r.z & 0xffff0000u), __builtin_bit_cast(float, r.w << 16), __builtin_bit_cast(float, r.w & 0xffff0000u)};
                        finish(r0 + acc[ai][bj][m][0] * w, r1 + acc[ai][bj][m][1] * w, off + bj * HALF, ssq); }
                    ssq += __shfl_xor(ssq, 16); ssq += __shfl_xor(ssq, 32); sv = fq == m ? ssq : sv; }
                ssp_out[(size_t)(row0 + ai * HALF + fq * 16) * 16 + u.pn * 4 + wc] = sv; }
        } else {
#pragma unroll
            for (int ai = 0; ai < 2; ++ai) {
                f32x4 rr[4][2][2];
#pragma unroll
                for (int m = 0; m < 4; ++m)
#pragma unroll
                    for (int bj = 0; bj < 2; ++bj) { const float* p = res32 + (size_t)(row0 + ai * HALF + m * 16) * 1024 + col0 + bj * HALF; rr[m][bj][0] = *(const f32x4*)p; rr[m][bj][1] = *(const f32x4*)(p + 4); }
#pragma unroll
                for (int m = 0; m < 4; ++m) { const int row = row0 + ai * HALF + m * 16; const size_t off = (size_t)row * 1024 + col0; float ssq = 0.f;
#pragma unroll
                    for (int bj = 0; bj < 2; ++bj) finish(rr[m][bj][0] + acc[ai][bj][m][0] * w, rr[m][bj][1] + acc[ai][bj][m][1] * w, off + bj * HALF, ssq);
                    ssq += __shfl_xor(ssq, 16); ssq += __shfl_xor(ssq, 32);
                    if (fq == 0) ssp_out[(size_t)row * 16 + u.pn * 4 + wc] = ssq; }
                asm volatile("" ::: "memory");
            }
        }
    }
};
struct EpiRowScale {
    static constexpr bool PERM = true, AFTER_DRAIN = false, AUX = true; static constexpr int NST = 16;
    bf16_t* P; const float* ssp; int ldp; PG8_LAS unsigned char* aux;
    PG8_STAGE_AUX()
    __device__ __forceinline__ void operator()(const f32x4 (&acc)[2][2][4][2], const Unit& u, int wr, int wc, int fr, int fq) const {
        const int row0 = u.pm * BM + wr * 64 + fr, col0 = u.pn * BM + wc * 32 + 8 * fq;
        float rsv[2][4];
#pragma unroll
        for (int ai = 0; ai < 2; ++ai)
#pragma unroll
            for (int m = 0; m < 4; ++m) rsv[ai][m] = row_rs_lds(aux, wr * 64 + fr + ai * HALF + m * 16, fq);
#pragma unroll
        for (int ai = 0; ai < 2; ++ai)
#pragma unroll
            for (int m = 0; m < 4; ++m) { const int row = row0 + ai * HALF + m * 16; const float rs = rsv[ai][m];
#pragma unroll
                for (int bj = 0; bj < 2; ++bj) { const f32x4 v0 = acc[ai][bj][m][0] * rs, v1 = acc[ai][bj][m][1] * rs;
                    u32x4 w; w.x = cvt_pk_bf16(v0[0], v0[1]); w.y = cvt_pk_bf16(v0[2], v0[3]); w.z = cvt_pk_bf16(v1[0], v1[1]); w.w = cvt_pk_bf16(v1[2], v1[3]);
                    *(u32x4*)(P + (size_t)row * ldp + col0 + bj * HALF) = w; }
                if (m & 1) asm volatile("" ::: "memory"); }
    }
};
struct EpiLora {
    static constexpr bool PERM = true, AFTER_DRAIN = false, AUX = false; static constexpr int NST = 0;
    bf16_t* L; const float* w0; const float* a0; int pn0;
    __device__ __forceinline__ void operator()(const f32x4 (&acc)[2][2][4][2], const Unit& u, int wr, int wc, int fr, int fq) const {
        const int pn = u.pn + pn0; const int row0 = u.pm * BM + wr * 64 + fr, col0 = pn * BM + wc * 32 + 8 * fq, type = pn >> 1, lc0 = (pn & 1) * BM + wc * 32 + 8 * fq;
        f32x4 bv[2][2];
#pragma unroll
        for (int bj = 0; bj < 2; ++bj)
#pragma unroll
            for (int n = 0; n < 2; ++n) bv[bj][n] = type == 0 ? *(const f32x4*)(w0 + lc0 + bj * HALF + 4 * n) : (type == 1 ? *(const f32x4*)(a0 + lc0 + bj * HALF + 4 * n) : (f32x4){0.f, 0.f, 0.f, 0.f});
#pragma unroll
        for (int ai = 0; ai < 2; ++ai)
#pragma unroll
            for (int m = 0; m < 4; ++m) { const int row = row0 + ai * HALF + m * 16;
#pragma unroll
                for (int bj = 0; bj < 2; ++bj) { f32x4 v0 = acc[ai][bj][m][0] + bv[bj][0], v1 = acc[ai][bj][m][1] + bv[bj][1];
                    if (type < 2) { const float sc = type == 0 ? -0.60653066f : 1.0f;
#pragma unroll
                        for (int e = 0; e < 4; ++e) { v0[e] = sc * fsigmoid(v0[e]); v1[e] = sc * fsigmoid(v1[e]); } }
                    u32x4 w; w.x = cvt_pk_bf16(v0[0], v0[1]); w.y = cvt_pk_bf16(v0[2], v0[3]); w.z = cvt_pk_bf16(v1[0], v1[1]); w.w = cvt_pk_bf16(v1[2], v1[3]);
                    *(u32x4*)(L + (size_t)row * 1536 + col0 + bj * HALF) = w; }
                if (m & 1) asm volatile("" ::: "memory"); }
    }
};
template <class Epi, class Sched, bool ALIGN_EPI = false, bool SP2 = false, bool A_BLK = false>
__device__ __forceinline__ void gemm_phase(PG8_LAS unsigned char* lds, const Gemm g, const Sched& S, const Epi& E, const int wid_) {
    const int wid = __builtin_amdgcn_readfirstlane(wid_), lane = lane_id_(), tid = wid * 64 + lane, wr = wid >> 2, wc = wid & 3, fr = lane & 15, fq = lane >> 4;
    const int K = g.ld ? g.ld : g.K, nt = g.K / BK;
    constexpr bool PRE = SP2 && Epi::NST != 0 && !Epi::AFTER_DRAIN;
    unsigned voffA[2], voffB[2];
#pragma unroll
    for (int i = 0; i < 2; ++i) { int R, C; stage_rc(tid * 16 + i * 8192, R, C); const int Rb = Epi::PERM ? ((R & ~31) + perm32(R & 31)) : R;
        voffA[i] = (unsigned)(R * (A_BLK ? BK : K) + C) * 2u; voffB[i] = (unsigned)(Rb * K + C) * 2u; }
    const size_t kstep = (size_t)(BK * 2);
    const size_t hstep = (size_t)HALF * K * 2;
    const size_t tstep = 2 * hstep;
    const size_t kstepA = A_BLK ? (size_t)(BM * BK * 2) : kstep, hstepA = A_BLK ? (size_t)(HALF * BK * 2) : hstep;
    const unsigned ldsw = (unsigned)wid * 1024u;
    const int aoff = lds_byte(wr * 64 + fr, fq * 8), boff = lds_byte(wc * 32 + fr, fq * 8);
#define PG8_SA(b, h) (((b) * 2 + (h)) * HTB)
#define PG8_SB(b, h) ((4 + (b) * 2 + (h)) * HTB)
#define PG8_STAGE(bufoff, gbase, voff) do { _Pragma("unroll") for (int _i = 0; _i < 2; ++_i) \
        __builtin_amdgcn_global_load_lds((const unsigned*)((const char*)(gbase) + (voff)[_i]), (PG8_LAS unsigned*)(lds + (bufoff) + ldsw + _i * 8192), 16, 0, 0); } while (0)
#define PG8_LDA(dst, b, h) do { _Pragma("unroll") for (int m = 0; m < 4; ++m) _Pragma("unroll") for (int k = 0; k < 2; ++k) dst[m][k] = *(const PG8_LAS bf16x8*)(lds + PG8_SA(b, h) + aoff + m * 2048 + k * 1024); } while (0)
#define PG8_LDB(dst, b, h) do { _Pragma("unroll") for (int n = 0; n < 2; ++n) _Pragma("unroll") for (int k = 0; k < 2; ++k) dst[n][k] = *(const PG8_LAS bf16x8*)(lds + PG8_SB(b, h) + boff + n * 2048 + k * 1024); } while (0)
#define PG8_MMA(ai, bj, At, Bt) do { __builtin_amdgcn_s_setprio(1); _Pragma("unroll") for (int m = 0; m < 4; ++m) _Pragma("unroll") for (int n = 0; n < 2; ++n) _Pragma("unroll") for (int k = 0; k < 2; ++k) \
        acc[ai][bj][m][n] = __builtin_amdgcn_mfma_f32_16x16x32_bf16(Bt[n][k], At[m][k], acc[ai][bj][m][n], 0, 0, 0); __builtin_amdgcn_s_setprio(0); } while (0)
#define PG8_WAIT_V(n) asm volatile("s_waitcnt vmcnt(" #n ")" ::: "memory")
#define PG8_WAIT_L(n) asm volatile("s_waitcnt lgkmcnt(" #n ")" ::: "memory")
#define PG8_BAR __builtin_amdgcn_s_barrier()
#define PG8_SCHED __builtin_amdgcn_sched_barrier(0)
    Unit cur, nxt; int ui = 0;
    if (!S.next(0, cur)) return;
    f32x4 acc[2][2][4][2];
#pragma unroll
    for (int a = 0; a < 2; ++a)
#pragma unroll
        for (int b = 0; b < 2; ++b)
#pragma unroll
            for (int m = 0; m < 4; ++m)
#pragma unroll
                for (int n = 0; n < 2; ++n) acc[a][b][m][n] = (f32x4){0.f, 0.f, 0.f, 0.f};
    bf16x8 At[4][2], B0[2][2], B1[2][2];
    const char* cA = (const char*)g.A + (size_t)cur.pm * tstep; const char* cB = (const char*)g.Bt + (size_t)cur.pn * tstep;
    S.a_ready(cur);
    if constexpr (SP2) {
        PG8_STAGE(PG8_SB(0, 0), cB, voffB); PG8_STAGE(PG8_SB(0, 1), cB + hstep, voffB); PG8_STAGE(PG8_SA(0, 0), cA, voffA); PG8_STAGE(PG8_SA(0, 1), cA + hstepA, voffA);
        if (wr == 1) PG8_BAR;
        PG8_WAIT_V(2); PG8_BAR;
        PG8_STAGE(PG8_SB(1, 0), cB + kstep, voffB); PG8_STAGE(PG8_SA(1, 0), cA + kstepA, voffA); PG8_STAGE(PG8_SB(1, 1), cB + hstep + kstep, voffB);
        if constexpr (PRE) { PG8_STAGE(PG8_SA(1, 1), cA + hstepA + kstepA, voffA); PG8_WAIT_V(0); PG8_BAR; }
        else { PG8_WAIT_V(6); PG8_BAR; }
    } else {
        PG8_STAGE(PG8_SB(0, 0), cB, voffB); PG8_STAGE(PG8_SA(0, 0), cA, voffA); PG8_STAGE(PG8_SB(0, 1), cB + hstep, voffB); PG8_STAGE(PG8_SA(0, 1), cA + hstepA, voffA);
        if (wr == 1) PG8_BAR;
        PG8_WAIT_V(4); PG8_BAR;
        PG8_STAGE(PG8_SB(1, 0), cB + kstep, voffB); PG8_STAGE(PG8_SA(1, 0), cA + kstepA, voffA); PG8_STAGE(PG8_SB(1, 1), cB + hstep + kstep, voffB);
        PG8_WAIT_V(6); PG8_BAR;
    }
    for (;;) {
        const bool has_next = S.next(ui + 1, nxt);
        const char* nA = has_next ? (const char*)g.A + (size_t)nxt.pm * tstep : cA; const char* nB = has_next ? (const char*)g.Bt + (size_t)nxt.pn * tstep : cB;
        if (ui > 0) { if constexpr (!PRE) PG8_WAIT_V(0); else if constexpr (Epi::NST == 8) PG8_WAIT_V(8); else if constexpr (Epi::NST == 16) PG8_WAIT_V(16); else if constexpr (Epi::NST == 24) PG8_WAIT_V(24); else { static_assert(Epi::NST == 40, "NST"); PG8_WAIT_V(40); } }
        for (int t = 0; t < nt; t += 2) {
            const bool last = (t == nt - 2);
            const char* a1 = cA + (size_t)(t + 1) * kstepA;
            const char* a2 = last ? nA : cA + (size_t)(t + 2) * kstepA; const char* b2 = last ? nB : cB + (size_t)(t + 2) * kstep;
            const char* a3 = a2 + kstepA; const char* b3 = b2 + kstep;
            if (last && has_next) S.a_ready(nxt);
            if constexpr (Epi::AUX) { if (last) E.stage_aux(cur, wid, lane); }
            if constexpr (SP2) {
            const bool t0 = PRE && t == 0;
            PG8_LDB(B0, 0, 0); PG8_LDB(B1, 0, 1); PG8_SCHED; PG8_LDA(At, 0, 0); if (!t0) PG8_STAGE(PG8_SA(1, 1), a1 + hstepA, voffA);
            if (t0) {} else if (Epi::AUX && last) PG8_WAIT_V(10); else PG8_WAIT_V(8);
            PG8_WAIT_L(0); PG8_BAR; PG8_MMA(0, 0, At, B0); PG8_MMA(0, 1, At, B1); PG8_BAR; PG8_SCHED;
            PG8_LDA(At, 0, 1); PG8_STAGE(PG8_SB(0, 0), b2, voffB); PG8_STAGE(PG8_SB(0, 1), b2 + hstep, voffB); PG8_STAGE(PG8_SA(0, 0), a2, voffA);
            if (t0) {} else if (Epi::AUX && last) PG8_WAIT_V(10); else PG8_WAIT_V(8);
            PG8_WAIT_L(0); PG8_BAR; PG8_MMA(1, 0, At, B0); PG8_MMA(1, 1, At, B1); PG8_BAR; PG8_SCHED;
            PG8_LDB(B0, 1, 0); PG8_LDB(B1, 1, 1); PG8_SCHED; PG8_LDA(At, 1, 0); PG8_STAGE(PG8_SA(0, 1), a2 + hstepA, voffA);
            if (!t0) PG8_WAIT_V(8);
            PG8_WAIT_L(0); PG8_BAR; PG8_MMA(0, 0, At, B0); PG8_MMA(0, 1, At, B1); PG8_BAR; PG8_SCHED;
            PG8_LDA(At, 1, 1); PG8_STAGE(PG8_SB(1, 0), b3, voffB); PG8_STAGE(PG8_SB(1, 1), b3 + hstep, voffB); PG8_STAGE(PG8_SA(1, 0), a3, voffA);
            PG8_WAIT_V(8); PG8_WAIT_L(0); PG8_BAR; PG8_MMA(1, 0, At, B0); PG8_MMA(1, 1, At, B1); PG8_BAR; PG8_SCHED;
            } else {
            PG8_LDB(B0, 0, 0); PG8_SCHED; PG8_LDA(At, 0, 0); PG8_STAGE(PG8_SA(1, 1), a1 + hstepA, voffA);
            PG8_WAIT_L(8); PG8_BAR; PG8_WAIT_L(0); PG8_MMA(0, 0, At, B0); PG8_BAR; PG8_SCHED;
            PG8_LDB(B1, 0, 1); PG8_STAGE(PG8_SB(0, 0), b2, voffB);
            PG8_BAR; PG8_WAIT_L(0); PG8_MMA(0, 1, At, B1); PG8_BAR;
            PG8_LDA(At, 0, 1); PG8_STAGE(PG8_SA(0, 0), a2, voffA);
            PG8_BAR; PG8_WAIT_L(0); PG8_MMA(1, 0, At, B0); PG8_BAR; PG8_SCHED;
            PG8_STAGE(PG8_SB(0, 1), b2 + hstep, voffB);
            PG8_WAIT_V(6); PG8_BAR; PG8_MMA(1, 1, At, B1); PG8_BAR;
            PG8_LDB(B0, 1, 0); PG8_SCHED; PG8_LDA(At, 1, 0); PG8_STAGE(PG8_SA(0, 1), a2 + hstepA, voffA);
            PG8_WAIT_L(8); PG8_BAR; PG8_WAIT_L(0); PG8_MMA(0, 0, At, B0); PG8_BAR; PG8_SCHED;
            PG8_LDB(B1, 1, 1); PG8_STAGE(PG8_SB(1, 0), b3, voffB);
            PG8_BAR; PG8_WAIT_L(0); PG8_MMA(0, 1, At, B1); PG8_BAR;
            PG8_LDA(At, 1, 1); PG8_STAGE(PG8_SA(1, 0), a3, voffA);
            PG8_BAR; PG8_WAIT_L(0); PG8_MMA(1, 0, At, B0); PG8_BAR; PG8_SCHED;
            PG8_STAGE(PG8_SB(1, 1), b3 + hstep, voffB);
            PG8_WAIT_V(6); PG8_BAR; PG8_MMA(1, 1, At, B1); PG8_BAR;
            }
        }
        if constexpr (ALIGN_EPI) { if (wr == 0) PG8_BAR; }
        if constexpr (PRE) PG8_STAGE(PG8_SA(1, 1), nA + hstepA + kstepA, voffA);
        if constexpr (!Epi::AFTER_DRAIN) { int fr_ = fr, fq_ = fq; asm volatile("" : "+v"(fr_), "+v"(fq_));
            E(acc, cur, wr, wc, fr_, fq_); S.done(cur); }
        if (!has_next) break;
#pragma unroll
        for (int a = 0; a < 2; ++a)
#pragma unroll
            for (int b = 0; b < 2; ++b)
#pragma unroll
                for (int m = 0; m < 4; ++m)
#pragma unroll
                    for (int n = 0; n < 2; ++n) acc[a][b][m][n] = (f32x4){0.f, 0.f, 0.f, 0.f};
        cur = nxt; cA = nA; cB = nB; ++ui;
        if constexpr (ALIGN_EPI) { if (wr == 1) PG8_BAR; }
    }
    PG8_WAIT_V(0);
    if constexpr (!ALIGN_EPI) { if (wr == 0) PG8_BAR; }
    PG8_BAR;
    if constexpr (Epi::AFTER_DRAIN) { E.fused(acc, cur, wr, wc, fr, fq, lds, wid, lane); S.done(cur); }
#undef PG8_SA
#undef PG8_SB
#undef PG8_STAGE
#undef PG8_LDA
#undef PG8_LDB
#undef PG8_MMA
#undef PG8_WAIT_V
#undef PG8_WAIT_L
#undef PG8_BAR
#undef PG8_SCHED
}
}

#ifndef PG8_SP2
#define PG8_SP2 true
#endif
#ifndef PG8_ALIGN
#define PG8_ALIGN true
#endif
#define GAS __attribute__((address_space(1)))
#define LAS __attribute__((address_space(3)))
typedef unsigned short bf16;
typedef unsigned v4u __attribute__((ext_vector_type(4)));
typedef float f32x4 __attribute__((ext_vector_type(4)));
typedef short bf16x8 __attribute__((ext_vector_type(8)));
typedef GAS unsigned gu32;
typedef GAS unsigned long long gu64;
#define RLX_AGENT __ATOMIC_RELAXED, __HIP_MEMORY_SCOPE_AGENT
#define LDS_WAIT() asm volatile("s_waitcnt lgkmcnt(0)" ::: "memory")
#define VM_WAIT() asm volatile("s_waitcnt vmcnt(0)" ::: "memory")
__device__ __forceinline__ unsigned long long rt() { return __builtin_amdgcn_s_memrealtime(); }
__device__ __forceinline__ unsigned f2bf(float f) { unsigned u = __builtin_bit_cast(unsigned, f); return (u + 0x7fffu + ((u >> 16) & 1u)) >> 16; }
__device__ __forceinline__ unsigned pk2(float lo, float hi) { return f2bf(lo) | (f2bf(hi) << 16); }

#define XB_TMO      128
#define XB_XCNT(j)  (256  + 64 * (j))
#define XB_XSUB(j)  (1280 + 64 * (j))
#define XB_XGEN(j)  (2304 + 64 * (j))
#define XB_TOP      3328
#define XB_TOPGEN   3392
#define XCD_BAR_WORDS 3456
#define XB_SPIN_CAP (1u << 18)

__device__ __forceinline__ unsigned xb_ld(unsigned* p)              { return __hip_atomic_load(p, __ATOMIC_RELAXED, __HIP_MEMORY_SCOPE_AGENT); }
__device__ __forceinline__ unsigned xb_add(unsigned* p, unsigned v) { return __hip_atomic_fetch_add(p, v, __ATOMIC_RELAXED, __HIP_MEMORY_SCOPE_AGENT); }
__device__ __forceinline__ unsigned xb_xcc_id() { return (unsigned)__builtin_amdgcn_s_getreg((3 << 11) | 20) & 0xFu; }
#define XB_SPIN(cond, bar) do { unsigned _sp = 0; while (cond) { __builtin_amdgcn_s_sleep(1); \
    if ((++_sp & 255u) == 0u) { if (xb_ld(&(bar)[XB_TMO])) break; if (_sp > XB_SPIN_CAP) { atomicAdd(&(bar)[XB_TMO], 1u); break; } } } } while (0)

struct XcdBarrier {
    unsigned* bar; unsigned x;
    unsigned G;
    unsigned wv;
    volatile LAS unsigned* st;
};

__device__ __forceinline__ XcdBarrier xcd_barrier_post(unsigned* bar, volatile LAS unsigned* st, unsigned wv, unsigned G = 0u) {
    XcdBarrier b; b.bar = bar; b.x = xb_xcc_id(); b.st = st; b.G = G; b.wv = wv;
    if (wv == 0u && lane_id_() == 0) (void)xb_add(&bar[XB_XCNT(b.x)], 1u);
    return b;
}
__device__ __forceinline__ void xcd_barrier_complete(unsigned* bar, unsigned x, unsigned& nloc, unsigned& nx, unsigned Gp) {
    const unsigned G = Gp ? Gp : gridDim.x * gridDim.y * gridDim.z;
    unsigned sum, cnt, mine, sp = 0u;
    for (;;) {
        sum = 0u; cnt = 0u; mine = 0u;
#pragma unroll
        for (unsigned j = 0; j < 16; ++j) { const unsigned c = xb_ld(&bar[XB_XCNT(j)]); sum += c; cnt += (c > 0u) ? 1u : 0u; mine = (j == x) ? c : mine; }
        if (sum == G) break;
        __builtin_amdgcn_s_sleep(1);
        if ((++sp & 255u) == 0u) { if (xb_ld(&bar[XB_TMO])) break; if (sp > XB_SPIN_CAP) { atomicAdd(&bar[XB_TMO], 1u); break; } }
    }
    nloc = mine > 0u ? mine : 1u; nx = cnt > 0u ? cnt : 1u;
}

__device__ __forceinline__ void xcd_barrier(const XcdBarrier& b) {
    asm volatile("s_waitcnt vmcnt(0)" ::: "memory");
    __syncthreads();
    if (b.wv == 0u && lane_id_() == 0) {
        unsigned* bar = b.bar;
        __builtin_amdgcn_s_waitcnt(0);
        unsigned nloc = b.st[0], nx = b.st[1];
        if (nloc == 0u) { xcd_barrier_complete(bar, b.x, nloc, nx, b.G); b.st[0] = nloc; b.st[1] = nx; }
        const unsigned old = xb_add(&bar[XB_XSUB(b.x)], 1u);
        const unsigned gen = old / nloc;
        if (old + 1u == (gen + 1u) * nloc) {
            __builtin_amdgcn_fence(__ATOMIC_RELEASE, "agent");
            asm volatile("s_waitcnt vmcnt(0)" ::: "memory");
            const unsigned og = xb_add(&bar[XB_TOP], 1u);
            const unsigned tg = og / nx;
            if (og + 1u == (tg + 1u) * nx) xb_add(&bar[XB_TOPGEN], 1u);
            else XB_SPIN(xb_ld(&bar[XB_TOPGEN]) == tg, bar);
            __builtin_amdgcn_fence(__ATOMIC_ACQUIRE, "agent");
            xb_add(&bar[XB_XGEN(b.x)], 1u);
            asm volatile("s_waitcnt vmcnt(0)" ::: "memory");
        } else {
            XB_SPIN(xb_ld(&bar[XB_XGEN(b.x)]) == gen, bar);
            __builtin_amdgcn_fence(__ATOMIC_ACQUIRE, "agent");
            asm volatile("s_waitcnt vmcnt(0)" ::: "memory");
        }
    }
    __syncthreads();
}

constexpr int NWAVES = 8;
constexpr int BATCH = 8, SEQ = 8192, D = 1024, FF = 2816;
constexpr int M = BATCH * SEQ;
constexpr int NGU = 2 * FF;
constexpr int PW = 3584;
constexpr int PROJ_ORIG = 3344;
constexpr int RB = 1600, GLA_ORIG_W = 1552;
constexpr int NLORA = 1536, KLORA = 256;
constexpr int NIN = 27;
constexpr size_t MiB = 1u << 20;
constexpr size_t WS_CTL = 0, CTL_ZERO_BYTES = 1 * MiB;
constexpr size_t WS_WGU1 = 2 * MiB, WS_WD1 = 14 * MiB, WS_WIN = 20 * MiB, WS_WOUT = 28 * MiB, WS_WGU2 = 30 * MiB, WS_WD2 = 42 * MiB, WS_WLORA = 48 * MiB;
constexpr size_t WS_SSP0 = 50 * MiB, WS_SSP1 = 54 * MiB, WS_SSP2 = 58 * MiB, WS_SSP3 = 62 * MiB;
constexpr size_t WS_XB = 68 * MiB;
constexpr size_t WS_Y = WS_XB;
constexpr size_t WS_OG = WS_XB + 64 * MiB;
constexpr size_t WS_HP = 196 * MiB;
constexpr size_t WS_MIXED = 644 * MiB;
constexpr size_t WS_LORA = 772 * MiB;
constexpr size_t WS_ALORA = 964 * MiB;
constexpr size_t WS_RS = 996 * MiB;
constexpr size_t WS_END = 998 * MiB;
constexpr int CW_BAR = 4096;
constexpr int CW_PROG = 65536;
constexpr int NSUB = 224;
constexpr int RING_OFF = 0, RING_BYTES = 147456, AUX_OFF = 131072;
constexpr int LDSCTL_OFF = RING_BYTES, MISC_OFF = LDSCTL_OFF + 320;
constexpr int LDS_BYTES = 151552;

struct Frame {
    LAS unsigned char* lds;
    volatile LAS unsigned* MISC;
    gu32* ctl;
    int tid, lane, wave;
    int vcu, G;
};
__device__ __forceinline__ float wave_sum(float v) {
#pragma unroll
    for (int o = 1; o < 64; o <<= 1) v += __shfl_xor(v, o);
    return v;
}
template <int MAP> __device__ __forceinline__ int rowmap(int n) {
    if (MAP == 1) return ((n >> 7) << 8) + (n & 127);
    if (MAP == 2) return ((n >> 7) << 8) + 128 + (n & 127);
    if (MAP == 3) return n < GLA_ORIG_W ? n : n + (RB - GLA_ORIG_W);
    return n;
}
template <int MAP> __device__ __forceinline__ void p0_item(const float* W, const float* gain, int K, int N, bf16* WT, LAS float* scr, int item, int lane) {
    const int nblk = (N + 31) / 32, kb = item / nblk, nb = item % nblk, k0 = 64 * kb, n0 = 32 * nb;
    const int nn = n0 + (lane & 31);
    float wv[32];
#pragma unroll
    for (int i = 0; i < 32; ++i) { const int kk = 2 * i + (lane >> 5); wv[i] = 0.f; if (nn < N) wv[i] = W[(size_t)(k0 + kk) * N + nn]; }
#pragma unroll
    for (int i = 0; i < 32; ++i) { const int kk = 2 * i + (lane >> 5); float v = wv[i]; if (gain) v *= gain[k0 + kk]; scr[kk * 33 + (lane & 31)] = v; }
    LDS_WAIT(); asm volatile("" ::: "memory");
    const int c = lane & 7;
#pragma unroll
    for (int j = 0; j < 4; ++j) { const int nl = (lane >> 3) + 8 * j; const LAS float* s = scr + (8 * c) * 33 + nl;
        v4u o; o.x = pk2(s[0 * 33], s[1 * 33]); o.y = pk2(s[2 * 33], s[3 * 33]); o.z = pk2(s[4 * 33], s[5 * 33]); o.w = pk2(s[6 * 33], s[7 * 33]);
        if (n0 + nl < N) *(GAS v4u*)(WT + (size_t)rowmap<MAP>(n0 + nl) * K + k0 + 8 * c) = o; }
    LDS_WAIT(); asm volatile("" ::: "memory");
}
struct Args { const float* in[NIN]; float* out; unsigned char* ws; int ph_lo, ph_hi, li, pad; };
static_assert(sizeof(Args) == NIN * 8 + 8 + 8 + 16, "Args has no padding");

__device__ __forceinline__ void p0_prologue(Frame& F, const Args& a) {
    LAS float* scr = (LAS float*)(F.lds + RING_OFF + F.wave * 16384);
    const int gw = F.vcu * NWAVES + F.wave, NGW = F.G * NWAVES;
    unsigned char* ws = a.ws;
    constexpr int I_GU = (D / 64) * (FF / 32), I_DN = (FF / 64) * (D / 32), I_IN = (D / 64) * ((PROJ_ORIG + 31) / 32), I_OUT = (D / 64) * (D / 32);
    constexpr int NITEMS = 2 * (2 * I_GU + I_DN) + I_IN + I_OUT;
    for (int it = gw; it < NITEMS; it += NGW) {
        int r = it;
        if (r < I_GU) { p0_item<1>(a.in[2], a.in[1], D, FF, (bf16*)(ws + WS_WGU1), scr, r, F.lane); continue; } r -= I_GU;
        if (r < I_GU) { p0_item<2>(a.in[3], a.in[1], D, FF, (bf16*)(ws + WS_WGU1), scr, r, F.lane); continue; } r -= I_GU;
        if (r < I_DN) { p0_item<0>(a.in[4], nullptr, FF, D, (bf16*)(ws + WS_WD1), scr, r, F.lane); continue; } r -= I_DN;
        if (r < I_GU) { p0_item<1>(a.in[23], a.in[22], D, FF, (bf16*)(ws + WS_WGU2), scr, r, F.lane); continue; } r -= I_GU;
        if (r < I_GU) { p0_item<2>(a.in[24], a.in[22], D, FF, (bf16*)(ws + WS_WGU2), scr, r, F.lane); continue; } r -= I_GU;
        if (r < I_DN) { p0_item<0>(a.in[25], nullptr, FF, D, (bf16*)(ws + WS_WD2), scr, r, F.lane); continue; } r -= I_DN;
        if (r < I_IN) { p0_item<3>(a.in[6], a.in[5], D, PROJ_ORIG, (bf16*)(ws + WS_WIN), scr, r, F.lane); continue; } r -= I_IN;
        p0_item<0>(a.in[21], nullptr, D, D, (bf16*)(ws + WS_WOUT), scr, r, F.lane);
    }
    { const int gt = gw * 64 + F.lane;
      if (gt < NLORA * (KLORA / 8)) { const int n = gt >> 5, kc = gt & 31, type = n >> 9, nl = n & 511; float v[8];
#pragma unroll
          for (int q = 0; q < 8; ++q) { const int k = 8 * kc + q; float x = 0.f;
              if (type == 0) { if (k < 64) x = a.in[12][k * 512 + nl]; } else if (type == 1) { if (k >= 64 && k < 128) x = a.in[14][(k - 64) * 512 + nl]; } else { if (k >= 128) x = a.in[15][(k - 128) * 512 + nl]; }
              v[q] = x; }
          v4u o; o.x = pk2(v[0], v[1]); o.y = pk2(v[2], v[3]); o.z = pk2(v[4], v[5]); o.w = pk2(v[6], v[7]);
          *(GAS v4u*)((bf16*)(ws + WS_WLORA) + (size_t)n * KLORA + 8 * kc) = o; } }
    const float* x = a.in[0]; bf16* xb = (bf16*)(ws + WS_XB); float* ssp = (float*)(ws + WS_SSP0);
#pragma unroll 4
    for (int m = gw; m < M; m += NGW) {
        const GAS f32x4* xr = (const GAS f32x4*)(x + (size_t)m * D) + F.lane;
        f32x4 v[4]; float s = 0.f;
#pragma unroll
        for (int j = 0; j < 4; ++j) { v[j] = xr[64 * j]; s += (v[j].x * v[j].x + v[j].y * v[j].y) + (v[j].z * v[j].z + v[j].w * v[j].w); }
        s = wave_sum(s);
        GAS unsigned long long* o8 = (GAS unsigned long long*)(xb + (size_t)m * D) + F.lane;
#pragma unroll
        for (int j = 0; j < 4; ++j) o8[64 * j] = (unsigned long long)pk2(v[j].x, v[j].y) | ((unsigned long long)pk2(v[j].z, v[j].w) << 32);
        if (F.lane < 16) ssp[(size_t)m * 16 + F.lane] = (F.lane == 0) ? s : 0.f;
    }
}
__device__ __forceinline__ void final_norm(Frame& F, const Args& a) {
    const int gw = F.vcu * NWAVES + F.wave, NGW = F.G * NWAVES;
    const float* ssp = (const float*)(a.ws + WS_SSP3); const float* g = a.in[26]; const bf16* xb = (const bf16*)(a.ws + WS_XB);
    f32x4 gv[4];
#pragma unroll
    for (int j = 0; j < 4; ++j) gv[j] = ((const GAS f32x4*)g)[F.lane + 64 * j];
#pragma unroll 2
    for (int m = gw; m < M; m += NGW) {
        float s = ssp[(size_t)m * 16 + (F.lane & 15)];
        s += __shfl_xor(s, 1); s += __shfl_xor(s, 2); s += __shfl_xor(s, 4); s += __shfl_xor(s, 8);
        const float rs = rsqrtf(s * (1.0f / 1024.0f) + 1e-6f);
        const GAS unsigned long long* xr = (const GAS unsigned long long*)(xb + (size_t)m * D) + F.lane;
        GAS f32x4* orow = (GAS f32x4*)(a.out + (size_t)m * D) + F.lane;
        unsigned long long w[4];
#pragma unroll
        for (int j = 0; j < 4; ++j) w[j] = xr[64 * j];
#pragma unroll
        for (int j = 0; j < 4; ++j) { const unsigned lo = (unsigned)w[j], hi = (unsigned)(w[j] >> 32);
            f32x4 v = {__builtin_bit_cast(float, lo << 16), __builtin_bit_cast(float, lo & 0xffff0000u), __builtin_bit_cast(float, hi << 16), __builtin_bit_cast(float, hi & 0xffff0000u)};
            orow[64 * j] = v * rs * gv[j]; }
    }
}


__device__ __forceinline__ float bf2f(bf16 v) { return __builtin_bit_cast(float, (unsigned)v << 16); }
__device__ __forceinline__ bf16 f2bf16(float f) { return (bf16)f2bf(f); }

namespace rw {
typedef float f32x2 __attribute__((ext_vector_type(2)));
template <int CTRL> __device__ __forceinline__ float dpp_mov(float x) { return __builtin_bit_cast(float, __builtin_amdgcn_update_dpp(0, __builtin_bit_cast(int, x), CTRL, 0xF, 0xF, true)); }
__device__ __forceinline__ float red16(float x) { x += dpp_mov<0xB1>(x); x += dpp_mov<0x4E>(x); x += dpp_mov<0x141>(x); x += dpp_mov<0x140>(x); return x; }
__device__ __forceinline__ void unpack8(const v4u w, float (&o)[8]) {
    o[0] = __builtin_bit_cast(float, w.x << 16); o[1] = __builtin_bit_cast(float, w.x & 0xffff0000u); o[2] = __builtin_bit_cast(float, w.y << 16); o[3] = __builtin_bit_cast(float, w.y & 0xffff0000u);
    o[4] = __builtin_bit_cast(float, w.z << 16); o[5] = __builtin_bit_cast(float, w.z & 0xffff0000u); o[6] = __builtin_bit_cast(float, w.w << 16); o[7] = __builtin_bit_cast(float, w.w & 0xffff0000u);
}
__device__ __forceinline__ float red8(float x) { x += dpp_mov<0xB1>(x); x += dpp_mov<0x4E>(x); x += dpp_mov<0x141>(x); return x; }
__device__ __forceinline__ void post_rows(Frame& F, const Args& args, int m0, int nrows) {
    const int lane = F.lane;
    const bf16* proj = (const bf16*)(args.ws + WS_HP); const bf16* lora = (const bf16*)(args.ws + WS_LORA); bf16* mixed = (bf16*)(args.ws + WS_MIXED);
    int c8 = 8 * lane;
    asm volatile("" : "+v"(c8));
    float mur[8], muk[8], muv[8], kac[8], rkc[8], lw[8], lb[8], nw[8];
#pragma unroll
    for (int q = 0; q < 8; ++q) { mur[q] = args.in[10][c8 + q]; muk[q] = args.in[10][512 + c8 + q]; muv[q] = args.in[10][1024 + c8 + q]; kac[q] = args.in[17][c8 + q]; rkc[q] = args.in[18][c8 + q];
        lw[q] = args.in[19][c8 + q]; lb[q] = args.in[20][c8 + q]; nw[q] = args.in[9][(c8 & 127) + q]; }
#pragma unroll 2
    for (int m = m0 + F.wave; m < m0 + nrows; m += NWAVES) {
        const bf16* p = proj + (size_t)m * PW + RB + c8; const bool has_prev = (m % SEQ) != 0; const bf16* pp = has_prev ? p - PW : p;
        const v4u wy = *(const v4u*)(mixed + (size_t)m * D + 512 + c8), wr_ = *(const v4u*)p, wk = *(const v4u*)(p + 512), wv = *(const v4u*)(p + 1024);
        const v4u qr = *(const v4u*)pp, qk = *(const v4u*)(pp + 512), qv = *(const v4u*)(pp + 1024);
        const v4u wa = *(const v4u*)(lora + (size_t)m * NLORA + 512 + c8), wg = *(const v4u*)(lora + (size_t)m * NLORA + 1024 + c8);
        const v4u wo = *(const v4u*)(mixed + (size_t)m * D + c8), wgo = *(const v4u*)(proj + (size_t)m * PW + 1024 + c8);
        float y[8], cr[8], ck[8], cv[8], pr[8], pk_[8], pv[8], a[8], g[8], o[8], go[8];
        unpack8(wy, y); unpack8(wr_, cr); unpack8(wk, ck); unpack8(wv, cv); unpack8(qr, pr); unpack8(qk, pk_); unpack8(qv, pv); unpack8(wa, a); unpack8(wg, g); unpack8(wo, o); unpack8(wgo, go);
        float vv[8], bsum = 0.f, ysum = 0.f;
#pragma unroll
        for (int q = 0; q < 8; ++q) { const float pq = has_prev ? pr[q] : 0.f, pkq = has_prev ? pk_[q] : 0.f, pvq = has_prev ? pv[q] : 0.f;
            const float r = cr[q] + mur[q] * (pq - cr[q]), k = ck[q] + muk[q] * (pkq - ck[q]); vv[q] = cv[q] + muv[q] * (pvq - cv[q]);
            const float kp = k * (1.0f + (a[q] - 1.0f) * kac[q]); bsum += r * kp * rkc[q]; ysum += y[q]; }
        const float bonus = red8(bsum), mean = red8(ysum) * (1.0f / 64.0f);
        float vsum = 0.f;
#pragma unroll
        for (int q = 0; q < 8; ++q) { y[q] -= mean; vsum += y[q] * y[q]; }
        const float rstd = rsqrtf(red8(vsum) * (1.0f / 64.0f) + 64e-5f);
        float res[8];
#pragma unroll
        for (int q = 0; q < 8; ++q) res[q] = (y[q] * rstd * lw[q] + lb[q] + bonus * vv[q]) * g[q];
        v4u ow; ow.x = pk2(res[0], res[1]); ow.y = pk2(res[2], res[3]); ow.z = pk2(res[4], res[5]); ow.w = pk2(res[6], res[7]);
        *(v4u*)(mixed + (size_t)m * D + 512 + c8) = ow;
        float osq = 0.f;
#pragma unroll
        for (int q = 0; q < 8; ++q) osq += o[q] * o[q];
        const float rs = rsqrtf(red16(osq) * (1.0f / 128.0f) + 1e-6f);
#pragma unroll
        for (int q = 0; q < 8; ++q) res[q] = o[q] * rs * nw[q] * go[q] * pg8::fsigmoid(go[q]);
        ow.x = pk2(res[0], res[1]); ow.y = pk2(res[2], res[3]); ow.z = pk2(res[4], res[5]); ow.w = pk2(res[6], res[7]);
        *(v4u*)(mixed + (size_t)m * D + c8) = ow;
    }
}
}

namespace rk {
typedef short bf16x8 __attribute__((ext_vector_type(8)));
typedef unsigned u32x2 __attribute__((ext_vector_type(2)));
constexpr int CB = 16, NBLK = SEQ / CB, NSLOT = 8, NCH = 2;
constexpr int P64 = 72, P32 = 40;
constexpr int O_AI = 0, O_RI = 2304, O_BT = 4608, O_KT = 6912, O_BK = 4608  , O_PS = 9728, O_MAK = 11008, O_TI = 12288, O_MR = 13568, O_VT = 14848, O_EG = 16896, SLOT = 17152;
constexpr int O_FLAGS = NSLOT * SLOT;
constexpr int O_STG = O_FLAGS + 64;
static_assert(O_STG + NCH * 1024 <= RING_BYTES, "rwkv chunk LDS map");
__device__ __forceinline__ float ubf(unsigned v) { return __builtin_bit_cast(float, v << 16); }
typedef __bf16 bf2_t __attribute__((ext_vector_type(2)));
__device__ __forceinline__ unsigned pk(float lo, float hi) { bf2_t v = {(__bf16)lo, (__bf16)hi}; return __builtin_bit_cast(unsigned, v); }
__device__ __forceinline__ bf16x8 mk8(unsigned a, unsigned b, unsigned c, unsigned d) { v4u t; t.x = a; t.y = b; t.z = c; t.w = d; return __builtin_bit_cast(bf16x8, t); }
__device__ __forceinline__ bf16x8 fr64(const LAS unsigned char* base, int row, int k0) { return *(const LAS bf16x8*)(base + (row * P64 + k0) * 2); }
__device__ __forceinline__ bf16x8 fr32(const LAS unsigned char* base, int row, int k0) { return *(const LAS bf16x8*)(base + (row * P32 + k0) * 2); }
__device__ __forceinline__ void store16_wt(bf16* p, v4u v) { asm volatile("global_store_dwordx4 %0, %1, off sc1\n\ts_nop 1" :: "v"((GAS v4u*)p), "v"(v) : "memory"); }
__device__ __forceinline__ void stage_put(LAS bf16* stg, f32x4 Y, int s, int fr, int fq) { const unsigned y01 = pk(Y[0], Y[1]), y23 = pk(Y[2], Y[3]); LAS bf16* o = stg + (4 * fq) * 32 + 16 * s + fr;
    o[0] = (bf16)(y01 & 0xffffu); o[32] = (bf16)(y01 >> 16); o[64] = (bf16)(y23 & 0xffffu); o[96] = (bf16)(y23 >> 16); }
__device__ __forceinline__ void stage_flush(const LAS bf16* stg, bf16* tile  , int lane) {
    asm volatile("s_waitcnt lgkmcnt(0)" ::: "memory"); const v4u v = *(const LAS v4u*)(stg + lane * 8); store16_wt(tile + (size_t)(lane >> 2) * D + 8 * (lane & 3), v); }
#define RK_MFMA(a, b, c) __builtin_amdgcn_mfma_f32_16x16x32_bf16(a, b, c, 0, 0, 0)
struct Raw { unsigned r[CB], k[CB], v[CB], ld[CB], a[CB], pr, pk_, pv; float rsv; };
struct Ctx { const bf16* proj; const bf16* lora; const float* rsn; bf16* Y; int mb, hc, h; float mur, muk, muv, kkc, kac; __amdgpu_buffer_rsrc_t pr, lr; };

#define RK_LD16(rs, vo, so) ((unsigned)(unsigned short)__builtin_amdgcn_raw_buffer_load_b16(rs, vo, so, 0))
__device__ __forceinline__ void prod_load(Raw& R, const Ctx& c, int blk, int j) {
    const int blkc = blk < NBLK ? blk : NBLK - 1; const int t0 = blkc * CB; const unsigned vo = (unsigned)j * 2u;
    const unsigned so = (unsigned)(((c.mb + t0) * PW + RB + c.hc) * 2), sl = (unsigned)(((c.mb + t0) * NLORA + c.hc) * 2);
    const unsigned sop = t0 > 0 ? so - (unsigned)(PW * 2) : so;
    R.pr = RK_LD16(c.pr, vo, sop); R.pk_ = RK_LD16(c.pr, vo + 1024u, sop); R.pv = RK_LD16(c.pr, vo + 2048u, sop);
#pragma unroll
    for (int i = 0; i < CB; ++i) { const unsigned si = so + (unsigned)(i * PW * 2), li = sl + (unsigned)(i * NLORA * 2);
        R.r[i] = RK_LD16(c.pr, vo, si); R.k[i] = RK_LD16(c.pr, vo + 1024u, si); R.v[i] = RK_LD16(c.pr, vo + 2048u, si); R.ld[i] = RK_LD16(c.lr, vo, li); R.a[i] = RK_LD16(c.lr, vo + 1024u, li); }
    R.rsv = c.rsn[(size_t)(c.mb + t0 + (j & 15)) * 8 + c.h];
}
__device__ __forceinline__ void put_prime(LAS unsigned char* img, f32x4 m, int fr, int fq, int off) {
    LAS bf16* q = (LAS bf16*)img + (4 * fq) * P32 + 8 * (fr >> 2) + (fr & 3) + off;
    const unsigned lo = pk(m[0], m[1]), hi = pk(m[2], m[3]);
    q[0] = (bf16)(lo & 0xffffu); q[P32] = (bf16)(lo >> 16); q[2 * P32] = (bf16)(hi & 0xffffu); q[3 * P32] = (bf16)(hi >> 16);
}
__device__ __forceinline__ void produce(Raw& R, const Ctx& c, LAS unsigned char* sp, int blk, int nextblk, int lane) {
    const int j = lane, fr = lane & 15, fq = lane >> 4;
    const int pj = 32 * (j >> 5) + 8 * ((j >> 2) & 3) + 4 * ((j >> 4) & 1) + (j & 3);
    LAS bf16* const AI = (LAS bf16*)(sp + O_AI) + pj; LAS bf16* const RI = (LAS bf16*)(sp + O_RI) + pj; LAS bf16* const BT = (LAS bf16*)(sp + O_BT) + pj; LAS bf16* const KT = (LAS bf16*)(sp + O_KT) + pj;
    const bool first = blk == 0;
    float pr = first ? 0.f : ubf(R.pr), pk0 = first ? 0.f : ubf(R.pk_), pv = first ? 0.f : ubf(R.pv);
    float G = 0.f, e0 = 1.0f; float bm[CB], km[CB]; unsigned vpk[CB / 2]; float vprev = 0.f;
#pragma unroll
    for (int i = 0; i < CB; ++i) {
        const float cr = ubf(R.r[i]), ck = ubf(R.k[i]), cv = ubf(R.v[i]);
        const float r = cr + c.mur * (pr - cr), k = ck + c.muk * (pk0 - ck), vv = cv + c.muv * (pv - cv);
        pr = cr; pk0 = ck; pv = cv;
        const float al = ubf(R.a[i]);
        G += ubf(R.ld[i]);
        const float e1 = __expf(G), em = __builtin_amdgcn_rcpf(e1);
        const float kk = k * c.kkc * __builtin_bit_cast(float, __builtin_amdgcn_readlane(__builtin_bit_cast(int, R.rsv), i));
        const float kp = k * (1.0f + (al - 1.0f) * c.kac), bb = kk * al;
        const unsigned ar = pk(-kk * e0, r * e1); bm[i] = bb * em; km[i] = kp * em; const unsigned bk = pk(bm[i], km[i]);
        AI[i * P64] = (bf16)(ar & 0xffffu); RI[i * P64] = (bf16)(ar >> 16); BT[i * P64] = (bf16)(bk & 0xffffu); KT[i * P64] = (bf16)(bk >> 16);
        if (i & 1) vpk[i >> 1] = pk(vprev, vv); else vprev = vv;
        e0 = e1;
    }
    const float eg = e0;
    prod_load(R, c, nextblk, j);
    asm volatile("s_waitcnt lgkmcnt(0)" ::: "memory");
    const bf16x8 a0 = fr64(sp + O_AI, fr, 8 * fq), a1 = fr64(sp + O_AI, fr, 32 + 8 * fq), r0 = fr64(sp + O_RI, fr, 8 * fq), r1 = fr64(sp + O_RI, fr, 32 + 8 * fq);
    const bf16x8 b0 = fr64(sp + O_BT, fr, 8 * fq), b1 = fr64(sp + O_BT, fr, 32 + 8 * fq), k0 = fr64(sp + O_KT, fr, 8 * fq), k1 = fr64(sp + O_KT, fr, 32 + 8 * fq);
    const f32x4 z = {0.f, 0.f, 0.f, 0.f};
    f32x4 Mab = RK_MFMA(a1, b1, RK_MFMA(a0, b0, z)), Mak = RK_MFMA(a1, k1, RK_MFMA(a0, k0, z)), Mrb = RK_MFMA(r1, b1, RK_MFMA(r0, b0, z)), Mrk = RK_MFMA(r1, k1, RK_MFMA(r0, k0, z));
#pragma unroll
    for (int q = 0; q < 4; ++q) { const int t = 4 * fq + q; const bool st = fr < t, in = fr <= t; Mab[q] = st ? Mab[q] : 0.f; Mak[q] = st ? Mak[q] : 0.f; Mrb[q] = in ? Mrb[q] : 0.f; Mrk[q] = in ? Mrk[q] : 0.f; }
    put_prime(sp + O_MAK, Mak, fr, fq, 0); put_prime(sp + O_MR, Mrb, fr, fq, 0); put_prime(sp + O_MR, Mrk, fr, fq, 4);
    f32x4 P = Mab, Tc = Mab;
#pragma unroll
    for (int q = 0; q < 4; ++q) if (fr == 4 * fq + q) Tc[q] += 1.0f;
    put_prime(sp + O_PS, P, fr, fq, 0); put_prime(sp + O_TI, Tc, fr, fq, 0);
#pragma unroll
    for (int it = 0; it < 3; ++it) {
        asm volatile("s_waitcnt lgkmcnt(0)" ::: "memory");
        const bf16x8 Pa = fr32(sp + O_PS, fr, 8 * fq), Ta = fr32(sp + O_TI, fr, 8 * fq);
        const bf16x8 Pb = mk8(pk(P[0], P[1]), pk(P[2], P[3]), 0u, 0u);
        const f32x4 P2 = RK_MFMA(Pa, Pb, z);
        const bf16x8 P2b = mk8(pk(P2[0], P2[1]), pk(P2[2], P2[3]), 0u, 0u);
        Tc = RK_MFMA(Ta, P2b, Tc);
        P = P2;
        asm volatile("s_waitcnt lgkmcnt(0)" ::: "memory");
        if (it < 2) put_prime(sp + O_PS, P, fr, fq, 0);
        put_prime(sp + O_TI, Tc, fr, fq, 0);
    }
    asm volatile("s_waitcnt lgkmcnt(0)" ::: "memory");
    { LAS v4u* bkrow = (LAS v4u*)(sp + O_BK + j * (P32 * 2));
#pragma unroll
      for (int q = 0; q < 4; ++q) { v4u o; o.x = pk(bm[4 * q], bm[4 * q + 1]); o.y = pk(bm[4 * q + 2], bm[4 * q + 3]); o.z = pk(km[4 * q], km[4 * q + 1]); o.w = pk(km[4 * q + 2], km[4 * q + 3]); bkrow[q] = o; }
      LAS v4u* vtrow = (LAS v4u*)(sp + O_VT + j * 32);
      v4u o0; o0.x = vpk[0]; o0.y = vpk[1]; o0.z = vpk[2]; o0.w = vpk[3]; vtrow[0] = o0; v4u o1; o1.x = vpk[4]; o1.y = vpk[5]; o1.z = vpk[6]; o1.w = vpk[7]; vtrow[1] = o1;
      ((LAS float*)(sp + O_EG))[j] = eg; }
}
__device__ __forceinline__ void chain_block(f32x4 (&S)[2][4], const LAS unsigned char* sp, LAS bf16* stg, bf16* ytile, int cw, int fr, int fq) {
    const bf16x8 ai0 = fr64(sp + O_AI, fr, 8 * fq), ai1 = fr64(sp + O_AI, fr, 32 + 8 * fq), ri0 = fr64(sp + O_RI, fr, 8 * fq), ri1 = fr64(sp + O_RI, fr, 32 + 8 * fq);
    const bf16x8 mak = fr32(sp + O_MAK, fr, 8 * fq), ti = fr32(sp + O_TI, fr, 8 * fq), mr = fr32(sp + O_MR, fr, 8 * fq);
    bf16x8 bk[4]; f32x4 eg[4];
#pragma unroll
    for (int mt = 0; mt < 4; ++mt) { bk[mt] = fr32(sp + O_BK, 16 * mt + fr, 8 * fq); eg[mt] = *(const LAS f32x4*)(sp + O_EG + (16 * mt + 4 * fq) * 4); }
    const f32x4 z = {0.f, 0.f, 0.f, 0.f};
#pragma unroll
    for (int s = 0; s < 2; ++s) {
        const bf16x8 Sf0 = mk8(pk(S[s][0][0], S[s][0][1]), pk(S[s][0][2], S[s][0][3]), pk(S[s][1][0], S[s][1][1]), pk(S[s][1][2], S[s][1][3]));
        const bf16x8 Sf1 = mk8(pk(S[s][2][0], S[s][2][1]), pk(S[s][2][2], S[s][2][3]), pk(S[s][3][0], S[s][3][1]), pk(S[s][3][2], S[s][3][3]));
        const u32x2 vh = *(const LAS u32x2*)(sp + O_VT + (32 * cw + 16 * s + fr) * 32 + 8 * fq);
        f32x4 U0 = RK_MFMA(ai0, Sf0, z); U0 = RK_MFMA(ai1, Sf1, U0); U0 = RK_MFMA(mak, mk8(vh.x, vh.y, 0u, 0u), U0);
        const f32x4 U = RK_MFMA(ti, mk8(pk(U0[0], U0[1]), pk(U0[2], U0[3]), 0u, 0u), z);
        const bf16x8 UV = mk8(pk(U[0], U[1]), pk(U[2], U[3]), vh.x, vh.y);
        f32x4 Y = RK_MFMA(ri0, Sf0, z); Y = RK_MFMA(ri1, Sf1, Y); Y = RK_MFMA(mr, UV, Y);
        stage_put(stg, Y, s, fr, fq);
#pragma unroll
        for (int mt = 0; mt < 4; ++mt) S[s][mt] = RK_MFMA(bk[mt], UV, S[s][mt]) * eg[mt];
    }
    stage_flush(stg, ytile, fr + 16 * fq);
}
#define RK_SPIN(cond) do { unsigned sp_ = 0; while (cond) { __builtin_amdgcn_s_sleep(1); if (++sp_ > (1u << 22)) break; } asm volatile("" ::: "memory"); } while (0)
__device__ __forceinline__ void chunk_phase(Frame& F, const Args& args, int head) {
    const int b = head >> 3, h = head & 7, j = F.lane, fr = F.lane & 15, fq = F.lane >> 4;
    Ctx c; c.proj = (const bf16*)(args.ws + WS_HP); c.lora = (const bf16*)(args.ws + WS_LORA); c.Y = (bf16*)(args.ws + WS_MIXED);     c.mb = b * SEQ; c.hc = h * 64; c.h = h; c.rsn = (const float*)(args.ws + WS_RS);
    c.pr = __builtin_amdgcn_make_buffer_rsrc((void*)c.proj, 0, (int)((size_t)M * PW * 2), 0x00020000); c.lr = __builtin_amdgcn_make_buffer_rsrc((void*)c.lora, 0, (int)((size_t)M * NLORA * 2), 0x00020000);
    c.mur = args.in[10][c.hc + j]; c.muk = args.in[10][512 + c.hc + j]; c.muv = args.in[10][1024 + c.hc + j]; c.kkc = args.in[16][c.hc + j]; c.kac = args.in[17][c.hc + j];
    for (int u = F.tid; u < (O_FLAGS + 64) / 4; u += NWAVES * 64) ((LAS unsigned*)F.lds)[u] = 0u;
    __syncthreads();
    volatile LAS unsigned* const ready = (volatile LAS unsigned*)(F.lds + O_FLAGS); volatile LAS unsigned* const done = ready + NSLOT; LAS unsigned* const next = (LAS unsigned*)(F.lds + O_FLAGS) + NSLOT + NCH;
    if (F.wave < NCH) {
        const int cw = F.wave;
        f32x4 S[2][4];
#pragma unroll
        for (int s = 0; s < 2; ++s)
#pragma unroll
            for (int mt = 0; mt < 4; ++mt) S[s][mt] = (f32x4){0.f, 0.f, 0.f, 0.f};
#pragma unroll 1
        for (int blk = 0; blk < NBLK; ++blk) { const int slot = blk & (NSLOT - 1);
            RK_SPIN(ready[slot] != (unsigned)(blk + 1));
            chain_block(S, F.lds + slot * SLOT, (LAS bf16*)(F.lds + O_STG + cw * 1024), c.Y + (size_t)(c.mb + blk * CB) * D + 512 + c.hc + 32 * cw, cw, fr, fq);
            asm volatile("s_waitcnt lgkmcnt(0)" ::: "memory");
            if (F.lane == 0) done[cw] = (unsigned)(blk + 1);
            if ((blk & 15) == 15) {
                const int pn_ = blk >> 4;
                if (pn_ > 0) { asm volatile("s_waitcnt vmcnt(16)" ::: "memory"); if (F.lane == 0) __hip_atomic_fetch_add((unsigned*)(F.ctl + CW_PROG) + 64 * (b * 32 + pn_ - 1), 1u, __ATOMIC_RELAXED, __HIP_MEMORY_SCOPE_AGENT); }
                if (blk == NBLK - 1) { asm volatile("s_waitcnt vmcnt(0)" ::: "memory"); if (F.lane == 0) __hip_atomic_fetch_add((unsigned*)(F.ctl + CW_PROG) + 64 * (b * 32 + pn_), 1u, __ATOMIC_RELAXED, __HIP_MEMORY_SCOPE_AGENT); } }
        }
    } else {
        Raw R;
        unsigned g0 = 0u; if (F.lane == 0) g0 = __hip_atomic_fetch_add(next, 1u, __ATOMIC_RELAXED, __HIP_MEMORY_SCOPE_WORKGROUP);
        int blk = (int)__builtin_amdgcn_readfirstlane(g0);
        prod_load(R, c, blk, j);
#pragma unroll 1
        while (blk < NBLK) {
            unsigned g1 = 0u; if (F.lane == 0) g1 = __hip_atomic_fetch_add(next, 1u, __ATOMIC_RELAXED, __HIP_MEMORY_SCOPE_WORKGROUP);
            const int nblk = (int)__builtin_amdgcn_readfirstlane(g1);
            if (blk >= NSLOT) { const unsigned need = (unsigned)(blk - NSLOT + 1); RK_SPIN(done[0] < need || done[1] < need); }
            const int slot = blk & (NSLOT - 1);
            produce(R, c, F.lds + slot * SLOT, blk, nblk, F.lane);
            asm volatile("s_waitcnt lgkmcnt(0)" ::: "memory");
            if (F.lane == 0) ready[slot] = (unsigned)(blk + 1);
            blk = nblk;
        }
    }
}
#undef RK_SPIN
#undef RK_MFMA
}

namespace gk {
using rk::stage_put; using rk::stage_flush; using rk::bf16x8; using rk::u32x2; using rk::pk; using rk::mk8; using rk::fr64; using rk::fr32; using rk::ubf; using rk::put_prime;
constexpr int CB = 16, NBLK = SEQ / CB, RND = 4, NRND = NBLK / RND, P64 = rk::P64, P32 = rk::P32;
constexpr int O_RI = 0, O_KT = 2304, O_BK = 2304  , O_MR = 7424, O_VT = 8704, O_EG = 12800, SLOT = 13056, O_STG = 2 * RND * SLOT;
static_assert(O_STG + 4 * 1024 <= RING_BYTES, "gla chunk LDS map");
#define GK_MFMA(a, b, c) __builtin_amdgcn_mfma_f32_16x16x32_bf16(a, b, c, 0, 0, 0)
struct Raw { unsigned q[CB], k[CB], la[CB], va[CB], vb[CB]; };
struct Ctx { const bf16* proj; const bf16* lap; bf16* OG; int mb, h; };

__device__ __forceinline__ void prod_load(Raw& R, const Ctx& c, int blk, int j) {
    const int blkc = blk < NBLK ? blk : NBLK - 1; const size_t m0 = (size_t)c.mb + (size_t)blkc * CB;
    const bf16* p = c.proj + m0 * PW + c.h * 64 + j; const bf16* l = c.proj + m0 * PW + (c.h == 0 ? 1536 : 3392 + 64 * (c.h - 1)) + j;   const bf16* pv = c.proj + m0 * PW + 512 + c.h * 128 + j;
#pragma unroll
    for (int i = 0; i < CB; ++i) { R.q[i] = p[(size_t)i * PW]; R.k[i] = p[(size_t)i * PW + 256]; R.la[i] = l[(size_t)i * PW]; R.va[i] = pv[(size_t)i * PW]; R.vb[i] = pv[(size_t)i * PW + 64]; }
}
__device__ __forceinline__ void produce(Raw& R, const Ctx& c, LAS unsigned char* sp, int nextblk, int lane) {
    const int j = lane, fr = lane & 15, fq = lane >> 4;
    const int pj = 32 * (j >> 5) + 8 * ((j >> 2) & 3) + 4 * ((j >> 4) & 1) + (j & 3);
    LAS bf16* const RI = (LAS bf16*)(sp + O_RI) + pj; LAS bf16* const KT = (LAS bf16*)(sp + O_KT) + pj;
    float G = 0.f, e1 = 1.0f; float km[CB]; unsigned va[CB / 2], vb[CB / 2];
#pragma unroll
    for (int i = 0; i < CB; ++i) {
        G += ubf(R.la[i]);
        e1 = __expf(G); const float em = __builtin_amdgcn_rcpf(e1);
        km[i] = ubf(R.k[i]) * em;
        const unsigned qk = pk(ubf(R.q[i]) * 0.125f * e1, km[i]);
        RI[i * P64] = (bf16)(qk & 0xffffu); KT[i * P64] = (bf16)(qk >> 16);
        if (i & 1) { va[i >> 1] = R.va[i - 1] | (R.va[i] << 16); vb[i >> 1] = R.vb[i - 1] | (R.vb[i] << 16); }
    }
    const float eg = e1;
    prod_load(R, c, nextblk, j);
    asm volatile("s_waitcnt lgkmcnt(0)" ::: "memory");
    const bf16x8 a0 = fr64(sp + O_RI, fr, 8 * fq), a1 = fr64(sp + O_RI, fr, 32 + 8 * fq), k0 = fr64(sp + O_KT, fr, 8 * fq), k1 = fr64(sp + O_KT, fr, 32 + 8 * fq);
    const f32x4 z = {0.f, 0.f, 0.f, 0.f};
    f32x4 Mqk = GK_MFMA(a1, k1, GK_MFMA(a0, k0, z));
#pragma unroll
    for (int q = 0; q < 4; ++q) Mqk[q] = (fr <= 4 * fq + q) ? Mqk[q] : 0.f;
    put_prime(sp + O_MR, Mqk, fr, fq, 4);
    asm volatile("s_waitcnt lgkmcnt(0)" ::: "memory");
    { LAS v4u* bkrow = (LAS v4u*)(sp + O_BK + j * (P32 * 2));
#pragma unroll
      for (int q = 0; q < 4; ++q) { v4u o; o.x = 0u; o.y = 0u; o.z = pk(km[4 * q] * eg, km[4 * q + 1] * eg); o.w = pk(km[4 * q + 2] * eg, km[4 * q + 3] * eg); bkrow[q] = o; }
      LAS v4u* vta = (LAS v4u*)(sp + O_VT + j * 32); LAS v4u* vtb = (LAS v4u*)(sp + O_VT + (j + 64) * 32);
      v4u o; o.x = va[0]; o.y = va[1]; o.z = va[2]; o.w = va[3]; vta[0] = o; o.x = va[4]; o.y = va[5]; o.z = va[6]; o.w = va[7]; vta[1] = o;
      o.x = vb[0]; o.y = vb[1]; o.z = vb[2]; o.w = vb[3]; vtb[0] = o; o.x = vb[4]; o.y = vb[5]; o.z = vb[6]; o.w = vb[7]; vtb[1] = o;
      ((LAS float*)(sp + O_EG))[j] = eg; }
}
__device__ __forceinline__ void chain_block(f32x4 (&S)[2][4], const LAS unsigned char* sp, LAS bf16* stg, bf16* otile, int cw, int fr, int fq) {
    const bf16x8 ri0 = fr64(sp + O_RI, fr, 8 * fq), ri1 = fr64(sp + O_RI, fr, 32 + 8 * fq), mr = fr32(sp + O_MR, fr, 8 * fq);
    bf16x8 bk[4];
#pragma unroll
    for (int mt = 0; mt < 4; ++mt) bk[mt] = fr32(sp + O_BK, 16 * mt + fr, 8 * fq);
    f32x4 eg[4];
#pragma unroll
    for (int mt = 0; mt < 4; ++mt) eg[mt] = *(const LAS f32x4*)(sp + O_EG + (16 * mt + 4 * fq) * 4);
    const f32x4 z = {0.f, 0.f, 0.f, 0.f};
#pragma unroll
    for (int s = 0; s < 2; ++s) {
        const bf16x8 Sf0 = mk8(pk(S[s][0][0], S[s][0][1]), pk(S[s][0][2], S[s][0][3]), pk(S[s][1][0], S[s][1][1]), pk(S[s][1][2], S[s][1][3]));
        const bf16x8 Sf1 = mk8(pk(S[s][2][0], S[s][2][1]), pk(S[s][2][2], S[s][2][3]), pk(S[s][3][0], S[s][3][1]), pk(S[s][3][2], S[s][3][3]));
        const u32x2 vh = *(const LAS u32x2*)(sp + O_VT + (32 * cw + 16 * s + fr) * 32 + 8 * fq);
        const bf16x8 V0 = mk8(0u, 0u, vh.x, vh.y);
        f32x4 Y = GK_MFMA(ri0, Sf0, z); Y = GK_MFMA(ri1, Sf1, Y); Y = GK_MFMA(mr, V0, Y);
        stage_put(stg, Y, s, fr, fq);
#pragma unroll
        for (int mt = 0; mt < 4; ++mt) S[s][mt] = GK_MFMA(bk[mt], V0, S[s][mt] * eg[mt]);
    }
    stage_flush(stg, otile, fr + 16 * fq);
}
__device__ __forceinline__ void chunk_phase(Frame& F, const Args& args, int blk_) {
    const int b = blk_ >> 2, h = blk_ & 3, j = F.lane, fr = F.lane & 15, fq = F.lane >> 4;
    Ctx c; c.proj = (const bf16*)(args.ws + WS_HP); c.lap = nullptr; c.OG = (bf16*)(args.ws + WS_MIXED);     c.mb = b * SEQ; c.h = h;
    for (int u = F.tid; u < 2 * RND * SLOT / 4; u += NWAVES * 64) ((LAS unsigned*)F.lds)[u] = 0u;
    __syncthreads();
    const bool producer = F.wave >= 4; const int pw = F.wave & 3, cw = F.wave & 3;
    f32x4 S[2][4];
#pragma unroll
    for (int s = 0; s < 2; ++s)
#pragma unroll
        for (int mt = 0; mt < 4; ++mt) S[s][mt] = (f32x4){0.f, 0.f, 0.f, 0.f};
    Raw R;
    if (producer) { prod_load(R, c, pw, j); produce(R, c, F.lds + pw * SLOT, RND + pw, F.lane); }
    __syncthreads();
    for (int rnd = 0; rnd < NRND; ++rnd) {
        const int cur = rnd & 1;
        if (producer) { const int blk = RND * (rnd + 1) + pw; if (blk < NBLK) produce(R, c, F.lds + ((cur ^ 1) * RND + pw) * SLOT, blk + RND, F.lane); }
        else {
#pragma unroll 1
            for (int q = 0; q < RND; ++q) { const int blk = RND * rnd + q;
                chain_block(S, F.lds + (cur * RND + q) * SLOT, (LAS bf16*)(F.lds + O_STG + cw * 1024), c.OG + (size_t)(c.mb + blk * CB) * D + h * 128 + 32 * cw, cw, fr, fq);
                if ((blk & 15) == 15) { const int pn_ = blk >> 4;
                    if (pn_ > 0) { asm volatile("s_waitcnt vmcnt(16)" ::: "memory"); if (F.lane == 0) __hip_atomic_fetch_add((unsigned*)(F.ctl + CW_PROG) + 64 * (b * 32 + pn_ - 1), 1u, __ATOMIC_RELAXED, __HIP_MEMORY_SCOPE_AGENT); }
                    if (blk == NBLK - 1) { asm volatile("s_waitcnt vmcnt(0)" ::: "memory"); if (F.lane == 0) __hip_atomic_fetch_add((unsigned*)(F.ctl + CW_PROG) + 64 * (b * 32 + pn_), 1u, __ATOMIC_RELAXED, __HIP_MEMORY_SCOPE_AGENT); } } } }
        __syncthreads();
    }
}
#undef GK_MFMA
}
struct OneUnit { int pm, pn;
    __device__ __forceinline__ bool next(int i, pg8::Unit& u) const { if (i) return false; u.pm = pm; u.pn = pn; return true; }
    __device__ __forceinline__ void a_ready(const pg8::Unit&) const {}
    __device__ __forceinline__ void done(const pg8::Unit&) const {} };
__global__ void __launch_bounds__(NWAVES * 64, 2) skel_fwd(Args args) {
    extern __shared__ __attribute__((aligned(16))) unsigned char lds[];
    Frame F;
    F.lds = (LAS unsigned char*)lds;
    F.MISC = (volatile LAS unsigned*)(F.lds + MISC_OFF);
    F.tid = threadIdx.x; F.lane = F.tid & 63; F.wave = __builtin_amdgcn_readfirstlane(F.tid >> 6);
    F.G = gridDim.x; { const int bx = blockIdx.x; F.vcu = (F.G % 8 == 0) ? (bx % 8) * (F.G / 8) + bx / 8 : bx; }
    unsigned char* ws = args.ws;
    F.ctl = (gu32*)(ws + WS_CTL);
    for (int u = F.tid; u < (LDS_BYTES - LDSCTL_OFF) / 4; u += NWAVES * 64) ((LAS unsigned*)(F.lds + LDSCTL_OFF))[u] = 0u;
    __syncthreads();
    const int lo = args.ph_lo, hi = args.ph_hi;
    XcdBarrier bar; bar.bar = (unsigned*)(F.ctl + CW_BAR) + args.li * XCD_BAR_WORDS; bar.x = 0; bar.st = nullptr; bar.G = 0u; bar.wv = (unsigned)F.wave;
    XcdBarrier sub = bar;
    if (hi - lo > 1) { bar = xcd_barrier_post((unsigned*)(F.ctl + CW_BAR) + args.li * XCD_BAR_WORDS, F.MISC + 8, (unsigned)F.wave);
        if (blockIdx.x < NSUB) sub = xcd_barrier_post((unsigned*)(F.ctl + CW_BAR) + (2 + args.li) * XCD_BAR_WORDS, F.MISC + 10, (unsigned)F.wave, NSUB); }
#define IN(k) (lo <= (k) && (k) < hi)
#define BOTH(k) (IN(k) && (k) + 1 < hi && (k) != 11)
#define FRESH() do { F.lane = lane_id_(); F.tid = F.wave * 64 + F.lane; } while (0)
#define GRID_BAR() do { xcd_barrier(bar); FRESH(); } while (0)
    bf16* const XB = (bf16*)(ws + WS_XB); bf16* const HP = (bf16*)(ws + WS_HP); bf16* const MIXED = (bf16*)(ws + WS_MIXED);
    float* const SSP0 = (float*)(ws + WS_SSP0); float* const SSP1 = (float*)(ws + WS_SSP1); float* const SSP2 = (float*)(ws + WS_SSP2); float* const SSP3 = (float*)(ws + WS_SSP3);

    if (IN(0)) { p0_prologue(F, args); if (BOTH(0)) GRID_BAR(); }
    if (IN(1)) {
        pg8::Gemm g{XB, (const bf16*)(ws + WS_WGU1), M, NGU, D}; pg8::StaticOrder S; S.init(M, NGU, F.G, (int)blockIdx.x, 1);
        pg8::EpiGateUp E{HP, SSP0, FF, F.lds + AUX_OFF};
        pg8::gemm_phase<pg8::EpiGateUp, pg8::StaticOrder, PG8_ALIGN, PG8_SP2>(F.lds + RING_OFF, g, S, E, F.wave); FRESH();
        if (BOTH(1)) GRID_BAR();
    }
    if (IN(2)) {
        pg8::Gemm g{HP, (const bf16*)(ws + WS_WD1), M, D, FF}; pg8::StaticOrder S; S.init(M, D, F.G, (int)blockIdx.x, 0);
        pg8::EpiResid<true, false> E{nullptr, XB, nullptr, XB, SSP1, 0.5f};
        pg8::gemm_phase<pg8::EpiResid<true, false>, pg8::StaticOrder, PG8_ALIGN, PG8_SP2, true>(F.lds + RING_OFF, g, S, E, F.wave); FRESH();
        if (BOTH(2)) GRID_BAR();
    }
    if (IN(3)) {
        pg8::Gemm g{XB, (const bf16*)(ws + WS_WIN), M, PW, D}; pg8::StaticOrder S; S.init(M, PW, F.G, (int)blockIdx.x, 1);
        pg8::EpiRowScale E{HP, SSP1, PW, F.lds + AUX_OFF};
        pg8::gemm_phase<pg8::EpiRowScale, pg8::StaticOrder, PG8_ALIGN, PG8_SP2>(F.lds + RING_OFF, g, S, E, F.wave); FRESH();
        if (BOTH(3)) GRID_BAR();
    }
    if (IN(4)) {
        const int gw = F.vcu * NWAVES + F.wave, NGW = F.G * NWAVES; const float* mu = args.in[10] + 1536 + 4 * F.lane; bf16* AL = (bf16*)(ws + WS_ALORA);
        const f32x4 mu4 = *(const f32x4*)mu;
        f32x4 aw[16];
#pragma unroll
        for (int r = 0; r < 16; ++r) aw[r] = *(const f32x4*)(args.in[7] + r * 256 + 4 * F.lane);
        const f32x4 ab4 = *(const f32x4*)(args.in[8] + 4 * F.lane);
        float muk8[8], kk8[8];
#pragma unroll
        for (int q = 0; q < 8; ++q) { muk8[q] = args.in[10][512 + 8 * F.lane + q]; kk8[q] = args.in[16][8 * F.lane + q]; }
#pragma unroll 2
        for (int m = gw; m < M; m += NGW) {
            const bf16* p = HP + (size_t)m * PW + RB + 1536 + 4 * F.lane;
            const unsigned long long cw = *(const unsigned long long*)p; unsigned long long pw_ = 0ull; if ((m % SEQ) != 0) pw_ = *(const unsigned long long*)(p - PW);
            const v4u al0 = *(const v4u*)(HP + (size_t)m * PW + 1536), al1 = *(const v4u*)(HP + (size_t)m * PW + 1544);
            float o[4];
#pragma unroll
            for (int q = 0; q < 4; ++q) { const float cur = __builtin_bit_cast(float, (unsigned)((cw >> (16 * q)) & 0xffffull) << 16), prev = __builtin_bit_cast(float, (unsigned)((pw_ >> (16 * q)) & 0xffffull) << 16);
                const float ps = cur + mu4[q] * (prev - cur);
                o[q] = F.lane < 16 ? 2.0f * pg8::fsigmoid(2.0f * ps) - 1.0f : (F.lane < 32 ? ps : pg8::fsigmoid(ps)); }
            *(unsigned long long*)(AL + (size_t)m * KLORA + 4 * F.lane) = (unsigned long long)pk2(o[0], o[1]) | ((unsigned long long)pk2(o[2], o[3]) << 32);
            const unsigned alw[8] = {al0.x, al0.y, al0.z, al0.w, al1.x, al1.y, al1.z, al1.w};
            f32x4 lg = ab4;
#pragma unroll
            for (int q = 0; q < 8; ++q) { lg += aw[2 * q] * __builtin_bit_cast(float, alw[q] << 16); lg += aw[2 * q + 1] * __builtin_bit_cast(float, alw[q] & 0xffff0000u); }
            float la[4];
#pragma unroll
            for (int q = 0; q < 4; ++q) la[q] = (fminf(lg[q], 0.f) - __logf(1.0f + __expf(-fabsf(lg[q])))) * (1.0f / 16.0f);
            { const int hh = F.lane >> 4, cc = (4 * F.lane) & 63;
              *(unsigned long long*)(HP + (size_t)m * PW + (hh == 0 ? 1536 : 3392 + 64 * (hh - 1)) + cc) = (unsigned long long)pk2(la[0], la[1]) | ((unsigned long long)pk2(la[2], la[3]) << 32); }
            { const bf16* kp_ = HP + (size_t)m * PW + RB + 512 + 8 * F.lane; const v4u kc = *(const v4u*)kp_; v4u kq = {0u, 0u, 0u, 0u}; if ((m % SEQ) != 0) kq = *(const v4u*)(kp_ - PW);
              const unsigned kcw[4] = {kc.x, kc.y, kc.z, kc.w}, kqw[4] = {kq.x, kq.y, kq.z, kq.w}; float s2 = 0.f;
#pragma unroll
              for (int q = 0; q < 4; ++q) { const float c0 = __builtin_bit_cast(float, kcw[q] << 16), c1 = __builtin_bit_cast(float, kcw[q] & 0xffff0000u), p0 = __builtin_bit_cast(float, kqw[q] << 16), p1 = __builtin_bit_cast(float, kqw[q] & 0xffff0000u);
                  const float k0 = (c0 + muk8[2 * q] * (p0 - c0)) * kk8[2 * q], k1 = (c1 + muk8[2 * q + 1] * (p1 - c1)) * kk8[2 * q + 1]; s2 += k0 * k0 + k1 * k1; }
              s2 += rw::dpp_mov<0xB1>(s2); s2 += rw::dpp_mov<0x4E>(s2); s2 += rw::dpp_mov<0x141>(s2);
              if ((F.lane & 7) == 0) ((float*)(ws + WS_RS))[(size_t)m * 8 + (F.lane >> 3)] = rsqrtf(fmaxf(s2, 1e-24f)); }
        }
        if (BOTH(4)) GRID_BAR();
    }
    if (IN(5)) {
        const int bx = blockIdx.x;
        if (bx < NSUB) {
            int klora = KLORA / 2; asm volatile("" : "+s"(klora));
            { pg8::Gemm g{(const bf16*)(ws + WS_ALORA), (const bf16*)(ws + WS_WLORA), M, 1024, klora, KLORA}; pg8::StaticOrder S; S.init(M, 1024, NSUB, bx);
              pg8::EpiLora E{(bf16*)(ws + WS_LORA), args.in[11], args.in[13], 0};
              pg8::gemm_phase<pg8::EpiLora, pg8::StaticOrder, PG8_ALIGN, PG8_SP2>(F.lds + RING_OFF, g, S, E, F.wave); FRESH(); }
            xcd_barrier(sub);
            if (bx < 64) rk::chunk_phase(F, args, bx);
            else { pg8::Gemm g{(const bf16*)(ws + WS_ALORA) + KLORA / 2, (const bf16*)(ws + WS_WLORA) + (size_t)1024 * KLORA + KLORA / 2, M, 512, klora, KLORA}; pg8::StaticOrder S; S.init(M, 512, NSUB - 64, bx - 64);
              pg8::EpiLora E{(bf16*)(ws + WS_LORA), args.in[11], args.in[13], 4};
              pg8::gemm_phase<pg8::EpiLora, pg8::StaticOrder, PG8_ALIGN, PG8_SP2>(F.lds + RING_OFF, g, S, E, F.wave); FRESH();
              gu32* const prog = F.ctl + CW_PROG;
              asm volatile("s_waitcnt vmcnt(0)" ::: "memory"); __syncthreads();
              if (F.tid == 0) { __builtin_amdgcn_fence(__ATOMIC_RELEASE, "agent"); asm volatile("s_waitcnt vmcnt(0)" ::: "memory");
                  __hip_atomic_fetch_add((unsigned*)(prog + 64 * 256), 1u, __ATOMIC_RELAXED, __HIP_MEMORY_SCOPE_AGENT);
                  unsigned sp_ = 0; while (__hip_atomic_load((unsigned*)(prog + 64 * 256), __ATOMIC_RELAXED, __HIP_MEMORY_SCOPE_AGENT) < (unsigned)(NSUB - 64)) { __builtin_amdgcn_s_sleep(4); if (++sp_ > (1u << 21)) break; } }
              __syncthreads();
            }
        } else gk::chunk_phase(F, args, bx - NSUB);
        { gu32* const prog = F.ctl + CW_PROG;
          const int wb = bx < 64 ? (bx >> 3) : (bx < NSUB ? ((bx - 64) & 7) : ((bx - NSUB) >> 2));
          if (bx < 64 || bx >= NSUB) {
              if (F.tid == 0) { unsigned sp_ = 0; while (__hip_atomic_load((unsigned*)(prog + 64 * 256), __ATOMIC_RELAXED, __HIP_MEMORY_SCOPE_AGENT) < (unsigned)(NSUB - 64)) { __builtin_amdgcn_s_sleep(16); if (++sp_ > (1u << 20)) break; } }
              __syncthreads(); }
              constexpr int NPU = 4 * (SEQ / 256);
              unsigned* const qpost = (unsigned*)(prog + 64 * (800 + 2 * wb)); unsigned* const qgemm = (unsigned*)(prog + 64 * (801 + 2 * wb));
              volatile LAS unsigned* const wsel = F.MISC + 12;
#pragma unroll 1
              for (int it_ = 0; it_ < 2 * NPU + 2; ++it_) {
                  if (F.tid == 0) { unsigned sel = 0xffffffffu, sp_ = 0;
                      for (;;) {
                          unsigned pq = __hip_atomic_load(qpost, __ATOMIC_RELAXED, __HIP_MEMORY_SCOPE_AGENT);
                          if (pq < (unsigned)NPU) {
                              if (__hip_atomic_load((unsigned*)(prog + 64 * (wb * 32 + (pq >> 2))), __ATOMIC_RELAXED, __HIP_MEMORY_SCOPE_AGENT) >= 32u) {
                                  if (__hip_atomic_compare_exchange_strong(qpost, &pq, pq + 1u, __ATOMIC_RELAXED, __ATOMIC_RELAXED, __HIP_MEMORY_SCOPE_AGENT)) { sel = pq; break; }
                                  continue; } }
                          unsigned gq = __hip_atomic_load(qgemm, __ATOMIC_RELAXED, __HIP_MEMORY_SCOPE_AGENT);
                          if (gq < (unsigned)NPU) {
                              if (__hip_atomic_load((unsigned*)(prog + 64 * (512 + wb * 32 + (gq >> 2))), __ATOMIC_RELAXED, __HIP_MEMORY_SCOPE_AGENT) >= 4u) {
                                  if (__hip_atomic_compare_exchange_strong(qgemm, &gq, gq + 1u, __ATOMIC_RELAXED, __ATOMIC_RELAXED, __HIP_MEMORY_SCOPE_AGENT)) { sel = 0x40000000u | gq; break; }
                                  continue; } }
                          else break;
                          __builtin_amdgcn_s_sleep(127); if (++sp_ > (1u << 18)) break; }
                      wsel[0] = sel; }
                  __syncthreads();
                  const unsigned sel = (unsigned)__builtin_amdgcn_readfirstlane((int)wsel[0]);
                  __syncthreads();
                  if (sel == 0xffffffffu) break;
                  const int k = (int)(sel & 0xffffu), tp = k >> 2, pb = wb, qr = k & 3, panel = pb * (SEQ / 256) + tp;
                  if (!(sel & 0x40000000u)) {
                      if (F.tid == 0) { __builtin_amdgcn_fence(__ATOMIC_ACQUIRE, "agent"); asm volatile("s_waitcnt vmcnt(0)" ::: "memory"); }
                      __syncthreads();
                      rw::post_rows(F, args, pb * SEQ + 256 * tp + 64 * qr, 64);
                      asm volatile("s_waitcnt vmcnt(0)" ::: "memory"); __syncthreads();
                      if (F.tid == 0) { __builtin_amdgcn_fence(__ATOMIC_RELEASE, "agent"); asm volatile("s_waitcnt vmcnt(0)" ::: "memory");
                          __hip_atomic_fetch_add((unsigned*)(prog + 64 * (512 + panel)), 1u, __ATOMIC_RELAXED, __HIP_MEMORY_SCOPE_AGENT); }
                  } else {
                      if (F.tid == 0) { __builtin_amdgcn_fence(__ATOMIC_ACQUIRE, "agent"); asm volatile("s_waitcnt vmcnt(0)" ::: "memory"); }
                      __syncthreads();
                      pg8::Gemm g8{MIXED, (const bf16*)(ws + WS_WOUT), M, D, D}; OneUnit S8{panel, qr};
                      pg8::EpiResid<true, false> E8{nullptr, XB, nullptr, XB, SSP2, 1.0f};
                      pg8::gemm_phase<pg8::EpiResid<true, false>, OneUnit, PG8_ALIGN, PG8_SP2>(F.lds + RING_OFF, g8, S8, E8, F.wave); FRESH(); }
              }
        }
        if (BOTH(5)) GRID_BAR();
    }
    if (IN(9)) {
        pg8::Gemm g{XB, (const bf16*)(ws + WS_WGU2), M, NGU, D}; pg8::StaticOrder S; S.init(M, NGU, F.G, (int)blockIdx.x);
        pg8::EpiGateUp E{HP, SSP2, FF, F.lds + AUX_OFF};
        pg8::gemm_phase<pg8::EpiGateUp, pg8::StaticOrder, PG8_ALIGN, PG8_SP2>(F.lds + RING_OFF, g, S, E, F.wave); FRESH();
        if (BOTH(9)) GRID_BAR();
    }
    if (IN(10)) {
        pg8::Gemm g{HP, (const bf16*)(ws + WS_WD2), M, D, FF}; pg8::StaticOrder S; S.init(M, D, F.G, (int)blockIdx.x, 1);
        pg8::EpiResid<true, false> E{nullptr, XB, nullptr, XB, SSP3, 0.5f};
        pg8::gemm_phase<pg8::EpiResid<true, false>, pg8::StaticOrder, PG8_ALIGN, PG8_SP2, true>(F.lds + RING_OFF, g, S, E, F.wave); FRESH();
        if (BOTH(10)) GRID_BAR();
    }
    if (IN(11)) { final_norm(F, args); }
#undef IN
#undef BOTH
}

static void launch_skel(int grid, hipStream_t stream, Args a, int lo, int hi, int li = 0) {
    a.ph_lo = lo; a.ph_hi = hi; a.li = li;
    hipLaunchKernelGGL(skel_fwd, dim3(grid), dim3(NWAVES * 64), LDS_BYTES, stream, a);
}
extern "C" void kernel_launch(void* const* d_in, const int* in_sizes, int n_in, void* d_out, int out_size, void* d_ws, size_t ws_size, hipStream_t stream) {
    static int grid = 0;
    if (grid == 0) {
        if (n_in != NIN || in_sizes[0] != M * D || out_size != M * D || ws_size < WS_END) { fprintf(stderr, "kernel_launch: unexpected shapes (n_in %d, in0 %d, out %d, ws %zu)\n", n_in, n_in > 0 ? in_sizes[0] : -1, out_size, ws_size); grid = -1; return; }
        int dev = 0, cus = 0;
        if (hipGetDevice(&dev) != hipSuccess || hipDeviceGetAttribute(&cus, hipDeviceAttributeMultiprocessorCount, dev) != hipSuccess) { grid = -1; return; }
        if (hipFuncSetAttribute((const void*)skel_fwd, hipFuncAttributeMaxDynamicSharedMemorySize, LDS_BYTES) != hipSuccess) { fprintf(stderr, "kernel_launch: hipFuncSetAttribute failed\n"); grid = -1; return; }
        (void)hipGetLastError();
        grid = cus;
    }
    if (grid < 0) return;
    if (hipMemsetAsync((char*)d_ws + WS_CTL, 0, CTL_ZERO_BYTES, stream) != hipSuccess) return;
    Args a{};
    for (int i = 0; i < NIN; ++i) a.in[i] = (const float*)d_in[i];
    a.out = (float*)d_out; a.ws = (unsigned char*)d_ws;
    launch_skel(grid, stream, a, 0, 12);
}
```

```cpp
#include <hip/hip_runtime.h>
#include <cstdio>
#include <cstdint>
__device__ __forceinline__ int lane_id_() { int l; asm volatile("v_mbcnt_lo_u32_b32 %0, -1, 0\n\tv_mbcnt_hi_u32_b32 %0, -1, %0" : "=v"(l)); return l; }
namespace pg8 {
#define PG8_LAS __attribute__((address_space(3)))
typedef unsigned short bf16_t;
typedef short bf16x8 __attribute__((ext_vector_type(8)));
typedef float f32x4 __attribute__((ext_vector_type(4)));
typedef unsigned u32x4 __attribute__((ext_vector_type(4)));
constexpr int BM = 256, BK = 64, HALF = 128, HTB = HALF * BK * 2  , STAGE_BYTES = 8 * HTB, NXCD = 8, WGM = 8;

__host__ __device__ __forceinline__ int lds_byte(int r, int c) { const int st = (r >> 4) * 2 + (c >> 5), rr = r & 15, cc = c & 31, ob = rr * 64 + cc * 2; return st * 1024 + (ob ^ (((ob >> 9) & 1) << 5)); }
__host__ __device__ __forceinline__ void stage_rc(int b, int& R, int& C) { const int st = b / 1024, sb = b % 1024, swz = sb ^ (((sb >> 9) & 1) << 5); R = (st >> 1) * 16 + swz / 64; C = (st & 1) * 32 + (swz % 64) / 2; }
__host__ __device__ __forceinline__ int perm32(int rho) { const int n = rho >> 4, i = rho & 15; return 8 * (i >> 2) + 4 * n + (i & 3); }

struct Unit { int pm, pn; };
struct Gemm { const bf16_t* A; const bf16_t* Bt; int M, N, K, ld; };

struct StaticOrder {
    int nM, nN, nwg, G, c, rev;
    __host__ __device__ void init(int M, int N, int G_, int c_, int rev_ = 0) { nM = M / BM; nN = N / BM; nwg = nM * nN; G = G_; c = c_; rev = rev_; }
    __host__ __device__ bool next(int i, Unit& u) const {
        const int L = i * G + c; if (L >= nwg) return false;
        int wgid = L; { const int q = nwg / NXCD, r = nwg % NXCD, xcd = wgid % NXCD, off = wgid / NXCD; wgid = (xcd < r ? xcd * (q + 1) : r * (q + 1) + (xcd - r) * q) + off; }
        const int nig = WGM * nN, gid = wgid / nig, fm = gid * WGM, gsz = (nM - fm) < WGM ? (nM - fm) : WGM;
        u.pm = fm + ((wgid % nig) % gsz); u.pn = (wgid % nig) / gsz; if (rev) u.pm = nM - 1 - u.pm; return true;
    }
    __device__ __forceinline__ void a_ready(const Unit&) const {}
    __device__ __forceinline__ void done(const Unit&) const {}
};

__device__ __forceinline__ unsigned cvt_pk_bf16(float lo, float hi) { unsigned r; asm volatile("v_cvt_pk_bf16_f32 %0, %1, %2" : "=v"(r) : "v"(lo), "v"(hi)); return r; }
__device__ __forceinline__ float fsigmoid(float x) { return __builtin_amdgcn_rcpf(1.0f + __builtin_amdgcn_exp2f(-1.44269504f * x)); }
constexpr float RMS_EPS = 1e-6f;
__device__ __forceinline__ float row_rs(const float* ssp, int row, int fq) {
    const f32x4 p = *(const f32x4*)(ssp + (size_t)row * 16 + 4 * fq);
    float s = (p[0] + p[1]) + (p[2] + p[3]); s += __shfl_xor(s, 16); s += __shfl_xor(s, 32);
    return rsqrtf(s * (1.0f / 1024.0f) + RMS_EPS);
}
__device__ __forceinline__ float row_rs_lds(const PG8_LAS unsigned char* aux, int lrow, int fq) {
    const f32x4 p = *(const PG8_LAS f32x4*)(aux + lrow * 64 + fq * 16);
    float s = (p[0] + p[1]) + (p[2] + p[3]); s += __shfl_xor(s, 16); s += __shfl_xor(s, 32);
    return rsqrtf(s * (1.0f / 1024.0f) + RMS_EPS);
}
__device__ __forceinline__ float row_ms_lds(const PG8_LAS unsigned char* aux, int lrow, int fq) {
    const f32x4 p = *(const PG8_LAS f32x4*)(aux + lrow * 64 + fq * 16);
    float s = (p[0] + p[1]) + (p[2] + p[3]); s += __shfl_xor(s, 16); s += __shfl_xor(s, 32);
    return s * (1.0f / 1024.0f) + RMS_EPS;
}
#define PG8_STAGE_AUX() __device__ __forceinline__ void stage_aux(const Unit& u, int wid, int lane) const { \
        const char* src = (const char*)(ssp + (size_t)u.pm * BM * 16) + wid * 1024 + lane * 16; \
        _Pragma("unroll") for (int i = 0; i < 2; ++i) __builtin_amdgcn_global_load_lds((const unsigned*)(src + i * 8192), (PG8_LAS unsigned*)(aux + wid * 1024 + i * 8192), 16, 0, 0); }
struct EpiGateUp {
    static constexpr bool PERM = true, AFTER_DRAIN = false, AUX = true; static constexpr int NST = 8;
    bf16_t* H; const float* ssp; int ldh; PG8_LAS unsigned char* aux;
    PG8_STAGE_AUX()
    __device__ __forceinline__ void operator()(const f32x4 (&acc)[2][2][4][2], const Unit& u, int wr, int wc, int fr, int fq) const {
        bf16_t* const Hb = H + ((size_t)(u.pm * (ldh / 64) + 2 * u.pn + (wc >> 1)) * BM + wr * 64 + fr) * 64 + (wc & 1) * 32 + 8 * fq;
#pragma unroll
        for (int ai = 0; ai < 2; ++ai) {
            float msv[4];
#pragma unroll
            for (int m = 0; m < 4; ++m) msv[m] = row_ms_lds(aux, wr * 64 + fr + ai * HALF + m * 16, fq);
#pragma unroll
            for (int m = 0; m < 4; ++m) { const float ms = msv[m], c1 = -1.44269504f * __builtin_amdgcn_rsqf(ms);
                float h[8];
#pragma unroll
                for (int n = 0; n < 2; ++n)
#pragma unroll
                    for (int e = 0; e < 4; ++e) { const float g = acc[ai][0][m][n][e], up = acc[ai][1][m][n][e];
                        const float d = __builtin_fmaf(__builtin_amdgcn_exp2f(g * c1), ms, ms);
                        h[4 * n + e] = (g * up) * __builtin_amdgcn_rcpf(d); }
                u32x4 w; w.x = cvt_pk_bf16(h[0], h[1]); w.y = cvt_pk_bf16(h[2], h[3]); w.z = cvt_pk_bf16(h[4], h[5]); w.w = cvt_pk_bf16(h[6], h[7]);
                *(u32x4*)(Hb + (ai * HALF + m * 16) * 64) = w;
                if (m & 1) asm volatile("" ::: "memory"); }
        }
    }
};
template <bool RES_BF16, bool OUT_F32> struct EpiResid {
    static constexpr bool PERM = true, AFTER_DRAIN = false, AUX = false; static constexpr int NST = 0;
    const float* res32; const bf16_t* res16; float* out32; bf16_t* xb; float* ssp_out; float w;
    __device__ __forceinline__ void finish(const f32x4& x0, const f32x4& x1, size_t off, float& ssq) const {
        if (OUT_F32) { *(f32x4*)(out32 + off) = x0; *(f32x4*)(out32 + off + 4) = x1; }
        ssq += (x0[0] * x0[0] + x0[1] * x0[1]) + (x0[2] * x0[2] + x0[3] * x0[3]) + (x1[0] * x1[0] + x1[1] * x1[1]) + (x1[2] * x1[2] + x1[3] * x1[3]);
        if constexpr (!OUT_F32) { u32x4 v; v.x = cvt_pk_bf16(x0[0], x0[1]); v.y = cvt_pk_bf16(x0[2], x0[3]); v.z = cvt_pk_bf16(x1[0], x1[1]); v.w = cvt_pk_bf16(x1[2], x1[3]); *(u32x4*)(xb + off) = v; }
    }
    __device__ __forceinline__ void operator()(const f32x4 (&acc)[2][2][4][2], const Unit& u, int wr, int wc, int fr, int fq) const {
        const int row0 = u.pm * BM + wr * 64 + fr, col0 = u.pn * BM + wc * 32 + 8 * fq;
        if constexpr (RES_BF16) {
            u32x4 rw[2][4][2];
#pragma unroll
            for (int ai = 0; ai < 2; ++ai)
#pragma unroll
                for (int m = 0; m < 4; ++m)
#pragma unroll
                    for (int bj = 0; bj < 2; ++bj) rw[ai][m][bj] = *(const u32x4*)(res16 + (size_t)(row0 + ai * HALF + m * 16) * 1024 + col0 + bj * HALF);
#pragma unroll
            for (int ai = 0; ai < 2; ++ai) {
                float sv = 0.f;
#pragma unroll
                for (int m = 0; m < 4; ++m) { const int row = row0 + ai * HALF + m * 16; const size_t off = (size_t)row * 1024 + col0; float ssq = 0.f;
#pragma unroll
                    for (int bj = 0; bj < 2; ++bj) { const u32x4 r = rw[ai][m][bj];
                        const f32x4 r0 = {__builtin_bit_cast(float, r.x << 16), __builtin_bit_cast(float, r.x & 0xffff0000u), __builtin_bit_cast(float, r.y << 16), __builtin_bit_cast(float, r.y & 0xffff0000u)};
                        const f32x4 r1 = {__builtin_bit_cast(float, r.z << 16), __builtin_bit_cast(float, r.z & 0xffff0000u), __builtin_bit_cast(float, r.w << 16), __builtin_bit_cast(float, r.w & 0xffff0000u)};
                        finish(r0 + acc[ai][bj][m][0] * w, r1 + acc[ai][bj][m][1] * w, off + bj * HALF, ssq); }
                    ssq += __shfl_xor(ssq, 16); ssq += __shfl_xor(ssq, 32); sv = fq == m ? ssq : sv; }
                ssp_out[(size_t)(row0 + ai * HALF + fq * 16) * 16 + u.pn * 4 + wc] = sv; }
        } else {
#pragma unroll
            for (int ai = 0; ai < 2; ++ai) {
                f32x4 rr[4][2][2];
#pragma unroll
                for (int m = 0; m < 4; ++m)
#pragma unroll
                    for (int bj = 0; bj < 2; ++bj) { const float* p = res32 + (size_t)(row0 + ai * HALF + m * 16) * 1024 + col0 + bj * HALF; rr[m][bj][0] = *(const f32x4*)p; rr[m][bj][1] = *(const f32x4*)(p + 4); }
#pragma unroll
                for (int m = 0; m < 4; ++m) { const int row = row0 + ai * HALF + m * 16; const size_t off = (size_t)row * 1024 + col0; float ssq = 0.f;
#pragma unroll
                    for (int bj = 0; bj < 2; ++bj) finish(rr[m][bj][0] + acc[ai][bj][m][0] * w, rr[m][bj][1] + acc[ai][bj][m][1] * w, off + bj * HALF, ssq);
                    ssq += __shfl_xor(ssq, 16); ssq += __shfl_xor(ssq, 32);
                    if (fq == 0) ssp_out[(size_t)row * 16 + u.pn * 4 + wc] = ssq; }
                asm volatile("" ::: "memory");
            }
        }
    }
};
struct EpiRowScale {
    static constexpr bool PERM = true, AFTER_DRAIN = false, AUX = true; static constexpr int NST = 16;
    bf16_t* P; const float* ssp; int ldp; PG8_LAS unsigned char* aux;
    PG8_STAGE_AUX()
    __device__ __forceinline__ void operator()(const f32x4 (&acc)[2][2][4][2], const Unit& u, int wr, int wc, int fr, int fq) const {
        const int row0 = u.pm * BM + wr * 64 + fr, col0 = u.pn * BM + wc * 32 + 8 * fq;
        float rsv[2][4];
#pragma unroll
        for (int ai = 0; ai < 2; ++ai)
#pragma unroll
            for (int m = 0; m < 4; ++m) rsv[ai][m] = row_rs_lds(aux, wr * 64 + fr + ai * HALF + m * 16, fq);
#pragma unroll
        for (int ai = 0; ai < 2; ++ai)
#pragma unroll
            for (int m = 0; m < 4; ++m) { const int row = row0 + ai * HALF + m * 16; const float rs = rsv[ai][m];
#pragma unroll
                for (int bj = 0; bj < 2; ++bj) { const f32x4 v0 = acc[ai][bj][m][0] * rs, v1 = acc[ai][bj][m][1] * rs;
                    u32x4 w; w.x = cvt_pk_bf16(v0[0], v0[1]); w.y = cvt_pk_bf16(v0[2], v0[3]); w.z = cvt_pk_bf16(v1[0], v1[1]); w.w = cvt_pk_bf16(v1[2], v1[3]);
                    *(u32x4*)(P + (size_t)row * ldp + col0 + bj * HALF) = w; }
                if (m & 1) asm volatile("" ::: "memory"); }
    }
};
struct EpiLora {
    static constexpr bool PERM = true, AFTER_DRAIN = false, AUX = false; static constexpr int NST = 0;
    bf16_t* L; const float* w0; const float* a0; int pn0;
    __device__ __forceinline__ void operator()(const f32x4 (&acc)[2][2][4][2], const Unit& u, int wr, int wc, int fr, int fq) const {
        const int pn = u.pn + pn0; const int row0 = u.pm * BM + wr * 64 + fr, col0 = pn * BM + wc * 32 + 8 * fq, type = pn >> 1, lc0 = (pn & 1) * BM + wc * 32 + 8 * fq;
        f32x4 bv[2][2];
#pragma unroll
        for (int bj = 0; bj < 2; ++bj)
#pragma unroll
            for (int n = 0; n < 2; ++n) bv[bj][n] = type == 0 ? *(const f32x4*)(w0 + lc0 + bj * HALF + 4 * n) : (type == 1 ? *(const f32x4*)(a0 + lc0 + bj * HALF + 4 * n) : (f32x4){0.f, 0.f, 0.f, 0.f});
#pragma unroll
        for (int ai = 0; ai < 2; ++ai)
#pragma unroll
            for (int m = 0; m < 4; ++m) { const int row = row0 + ai * HALF + m * 16;
#pragma unroll
                for (int bj = 0; bj < 2; ++bj) { f32x4 v0 = acc[ai][bj][m][0] + bv[bj][0], v1 = acc[ai][bj][m][1] + bv[bj][1];
                    if (type < 2) { const float sc = type == 0 ? -0.60653066f : 1.0f;
#pragma unroll
                        for (int e = 0; e < 4; ++e) { v0[e] = sc * fsigmoid(v0[e]); v1[e] = sc * fsigmoid(v1[e]); } }
                    u32x4 w; w.x = cvt_pk_bf16(v0[0], v0[1]); w.y = cvt_pk_bf16(v0[2], v0[3]); w.z = cvt_pk_bf16(v1[0], v1[1]); w.w = cvt_pk_bf16(v1[2], v1[3]);
                    *(u32x4*)(L + (size_t)row * 1536 + col0 + bj * HALF) = w; }
                if (m & 1) asm volatile("" ::: "memory"); }
    }
};
template <class Epi, class Sched, bool ALIGN_EPI = false, bool SP2 = false, bool A_BLK = false>
__device__ __forceinline__ void gemm_phase(PG8_LAS unsigned char* lds, const Gemm g, const Sched& S, const Epi& E, const int wid_) {
    const int wid = __builtin_amdgcn_readfirstlane(wid_), lane = lane_id_(), tid = wid * 64 + lane, wr = wid >> 2, wc = wid & 3, fr = lane & 15, fq = lane >> 4;
    const int K = g.ld ? g.ld : g.K, nt = g.K / BK;
    constexpr bool PRE = SP2 && Epi::NST != 0 && !Epi::AFTER_DRAIN;
    unsigned voffA[2], voffB[2];
#pragma unroll
    for (int i = 0; i < 2; ++i) { int R, C; stage_rc(tid * 16 + i * 8192, R, C); const int Rb = Epi::PERM ? ((R & ~31) + perm32(R & 31)) : R;
        voffA[i] = (unsigned)(R * (A_BLK ? BK : K) + C) * 2u; voffB[i] = (unsigned)(Rb * K + C) * 2u; }
    const size_t kstep = (size_t)(BK * 2);
    const size_t hstep = (size_t)HALF * K * 2;
    const size_t tstep = 2 * hstep;
    const size_t kstepA = A_BLK ? (size_t)(BM * BK * 2) : kstep, hstepA = A_BLK ? (size_t)(HALF * BK * 2) : hstep;
    const unsigned ldsw = (unsigned)wid * 1024u;
    const int aoff = lds_byte(wr * 64 + fr, fq * 8), boff = lds_byte(wc * 32 + fr, fq * 8);
#define PG8_SA(b, h) (((b) * 2 + (h)) * HTB)
#define PG8_SB(b, h) ((4 + (b) * 2 + (h)) * HTB)
#define PG8_STAGE(bufoff, gbase, voff) do { _Pragma("unroll") for (int _i = 0; _i < 2; ++_i) \
        __builtin_amdgcn_global_load_lds((const unsigned*)((const char*)(gbase) + (voff)[_i]), (PG8_LAS unsigned*)(lds + (bufoff) + ldsw + _i * 8192), 16, 0, 0); } while (0)
#define PG8_LDA(dst, b, h) do { _Pragma("unroll") for (int m = 0; m < 4; ++m) _Pragma("unroll") for (int k = 0; k < 2; ++k) dst[m][k] = *(const PG8_LAS bf16x8*)(lds + PG8_SA(b, h) + aoff + m * 2048 + k * 1024); } while (0)
#define PG8_LDB(dst, b, h) do { _Pragma("unroll") for (int n = 0; n < 2; ++n) _Pragma("unroll") for (int k = 0; k < 2; ++k) dst[n][k] = *(const PG8_LAS bf16x8*)(lds + PG8_SB(b, h) + boff + n * 2048 + k * 1024); } while (0)
#define PG8_MMA(ai, bj, At, Bt) do { __builtin_amdgcn_s_setprio(1); _Pragma("unroll") for (int m = 0; m < 4; ++m) _Pragma("unroll") for (int n = 0; n < 2; ++n) _Pragma("unroll") for (int k = 0; k < 2; ++k) \
        acc[ai][bj][m][n] = __builtin_amdgcn_mfma_f32_16x16x32_bf16(Bt[n][k], At[m][k], acc[ai][bj][m][n], 0, 0, 0); __builtin_amdgcn_s_setprio(0); } while (0)
#define PG8_WAIT_V(n) asm volatile("s_waitcnt vmcnt(" #n ")" ::: "memory")
#define PG8_WAIT_L(n) asm volatile("s_waitcnt lgkmcnt(" #n ")" ::: "memory")
#define PG8_BAR __builtin_amdgcn_s_barrier()
#define PG8_SCHED __builtin_amdgcn_sched_barrier(0)
    Unit cur, nxt; int ui = 0;
    if (!S.next(0, cur)) return;
    f32x4 acc[2][2][4][2];
#pragma unroll
    for (int a = 0; a < 2; ++a)
#pragma unroll
        for (int b = 0; b < 2; ++b)
#pragma unroll
            for (int m = 0; m < 4; ++m)
#pragma unroll
                for (int n = 0; n < 2; ++n) acc[a][b][m][n] = (f32x4){0.f, 0.f, 0.f, 0.f};
    bf16x8 At[4][2], B0[2][2], B1[2][2];
    const char* cA = (const char*)g.A + (size_t)cur.pm * tstep; const char* cB = (const char*)g.Bt + (size_t)cur.pn * tstep;
    S.a_ready(cur);
    if constexpr (SP2) {
        PG8_STAGE(PG8_SB(0, 0), cB, voffB); PG8_STAGE(PG8_SB(0, 1), cB + hstep, voffB); PG8_STAGE(PG8_SA(0, 0), cA, voffA); PG8_STAGE(PG8_SA(0, 1), cA + hstepA, voffA);
        if (wr == 1) PG8_BAR;
        PG8_WAIT_V(2); PG8_BAR;
        PG8_STAGE(PG8_SB(1, 0), cB + kstep, voffB); PG8_STAGE(PG8_SA(1, 0), cA + kstepA, voffA); PG8_STAGE(PG8_SB(1, 1), cB + hstep + kstep, voffB);
        if constexpr (PRE) { PG8_STAGE(PG8_SA(1, 1), cA + hstepA + kstepA, voffA); PG8_WAIT_V(0); PG8_BAR; }
        else { PG8_WAIT_V(6); PG8_BAR; }
    } else {
        PG8_STAGE(PG8_SB(0, 0), cB, voffB); PG8_STAGE(PG8_SA(0, 0), cA, voffA); PG8_STAGE(PG8_SB(0, 1), cB + hstep, voffB); PG8_STAGE(PG8_SA(0, 1), cA + hstepA, voffA);
        if (wr == 1) PG8_BAR;
        PG8_WAIT_V(4); PG8_BAR;
        PG8_STAGE(PG8_SB(1, 0), cB + kstep, voffB); PG8_STAGE(PG8_SA(1, 0), cA + kstepA, voffA); PG8_STAGE(PG8_SB(1, 1), cB + hstep + kstep, voffB);
        PG8_WAIT_V(6); PG8_BAR;
    }
    for (;;) {
        const bool has_next = S.next(ui + 1, nxt);
        const char* nA = has_next ? (const char*)g.A + (size_t)nxt.pm * tstep : cA; const char* nB = has_next ? (const char*)g.Bt + (size_t)nxt.pn * tstep : cB;
        if (ui > 0) { if constexpr (!PRE) PG8_WAIT_V(0); else if constexpr (Epi::NST == 8) PG8_WAIT_V(8); else if constexpr (Epi::NST == 16) PG8_WAIT_V(16); else if constexpr (Epi::NST == 24) PG8_WAIT_V(24); else { static_assert(Epi::NST == 40, "NST"); PG8_WAIT_V(40); } }
        for (int t = 0; t < nt; t += 2) {
            const bool last = (t == nt - 2);
            const char* a1 = cA + (size_t)(t + 1) * kstepA;
            const char* a2 = last ? nA : cA + (size_t)(t + 2) * kstepA; const char* b2 = last ? nB : cB + (size_t)(t + 2) * kstep;
            const char* a3 = a2 + kstepA; const char* b3 = b2 + kstep;
            if (last && has_next) S.a_ready(nxt);
            if constexpr (Epi::AUX) { if (last) E.stage_aux(cur, wid, lane); }
            if constexpr (SP2) {
            const bool t0 = PRE && t == 0;
            PG8_LDB(B0, 0, 0); PG8_LDB(B1, 0, 1); PG8_SCHED; PG8_LDA(At, 0, 0); if (!t0) PG8_STAGE(PG8_SA(1, 1), a1 + hstepA, voffA);
            if (t0) {} else if (Epi::AUX && last) PG8_WAIT_V(10); else PG8_WAIT_V(8);
            PG8_WAIT_L(0); PG8_BAR; PG8_MMA(0, 0, At, B0); PG8_MMA(0, 1, At, B1); PG8_BAR; PG8_SCHED;
            PG8_LDA(At, 0, 1); PG8_STAGE(PG8_SB(0, 0), b2, voffB); PG8_STAGE(PG8_SB(0, 1), b2 + hstep, voffB); PG8_STAGE(PG8_SA(0, 0), a2, voffA);
            if (t0) {} else if (Epi::AUX && last) PG8_WAIT_V(10); else PG8_WAIT_V(8);
            PG8_WAIT_L(0); PG8_BAR; PG8_MMA(1, 0, At, B0); PG8_MMA(1, 1, At, B1); PG8_BAR; PG8_SCHED;
            PG8_LDB(B0, 1, 0); PG8_LDB(B1, 1, 1); PG8_SCHED; PG8_LDA(At, 1, 0); PG8_STAGE(PG8_SA(0, 1), a2 + hstepA, voffA);
            if (!t0) PG8_WAIT_V(8);
            PG8_WAIT_L(0); PG8_BAR; PG8_MMA(0, 0, At, B0); PG8_MMA(0, 1, At, B1); PG8_BAR; PG8_SCHED;
            PG8_LDA(At, 1, 1); PG8_STAGE(PG8_SB(1, 0), b3, voffB); PG8_STAGE(PG8_SB(1, 1), b3 + hstep, voffB); PG8_STAGE(PG8_SA(1, 0), a3, voffA);
            PG8_WAIT_V(8); PG8_WAIT_L(0); PG8_BAR; PG8_MMA(1, 0, At, B0); PG8_MMA(1, 1, At, B1); PG8_BAR; PG8_SCHED;
            } else {
            PG8_LDB(B0, 0, 0); PG8_SCHED; PG8_LDA(At, 0, 0); PG8_STAGE(PG8_SA(1, 1), a1 + hstepA, voffA);
            PG8_WAIT_L(8); PG8_BAR; PG8_WAIT_L(0); PG8_MMA(0, 0, At, B0); PG8_BAR; PG8_SCHED;
            PG8_LDB(B1, 0, 1); PG8_STAGE(PG8_SB(0, 0), b2, voffB);
            PG8_BAR; PG8_WAIT_L(0); PG8_MMA(0, 1, At, B1); PG8_BAR;
            PG8_LDA(At, 0, 1); PG8_STAGE(PG8_SA(0, 0), a2, voffA);
            PG8_BAR; PG8_WAIT_L(0); PG8_MMA(1, 0, At, B0); PG8_BAR; PG8_SCHED;
            PG8_STAGE(PG8_SB(0, 1), b2 + hstep, voffB);
            PG8_WAIT_V(6); PG8_BAR; PG8_MMA(1, 1, At, B1); PG8_BAR;
            PG8_LDB(B0, 1, 0); PG8_SCHED; PG8_LDA(At, 1, 0); PG8_STAGE(PG8_SA(0, 1), a2 + hstepA, voffA);
            PG8_WAIT_L(8); PG8_BAR; PG8_WAIT_L(0); PG8_MMA(0, 0, At, B0); PG8_BAR; PG8_SCHED;
            PG8_LDB(B1, 1, 1); PG8_STAGE(PG8_SB(1, 0), b3, voffB);
            PG8_BAR; PG8_WAIT_L(0); PG8_MMA(0, 1, At, B1); PG8_BAR;
            PG8_LDA(At, 1, 1); PG8_STAGE(PG8_SA(1, 0), a3, voffA);
            PG8_BAR; PG8_WAIT_L(0); PG8_MMA(1, 0, At, B0); PG8_BAR; PG8_SCHED;
            PG8_STAGE(PG8_SB(1, 1), b3 + hstep, voffB);
            PG8_WAIT_V(6); PG8_BAR; PG8_MMA(1, 1, At, B1); PG8_BAR;
            }
        }
        if constexpr (ALIGN_EPI) { if (wr == 0) PG8_BAR; }
        if constexpr (PRE) PG8_STAGE(PG8_SA(1, 1), nA + hstepA + kstepA, voffA);
        if constexpr (!Epi::AFTER_DRAIN) { int fr_ = fr, fq_ = fq; asm volatile("" : "+v"(fr_), "+v"(fq_));
            E(acc, cur, wr, wc, fr_, fq_); S.done(cur); }
        if (!has_next) break;
#pragma unroll
        for (int a = 0; a < 2; ++a)
#pragma unroll
            for (int b = 0; b < 2; ++b)
#pragma unroll
                for (int m = 0; m < 4; ++m)
#pragma unroll
                    for (int n = 0; n < 2; ++n) acc[a][b][m][n] = (f32x4){0.f, 0.f, 0.f, 0.f};
        cur = nxt; cA = nA; cB = nB; ++ui;
        if constexpr (ALIGN_EPI) { if (wr == 1) PG8_BAR; }
    }
    PG8_WAIT_V(0);
    if constexpr (!ALIGN_EPI) { if (wr == 0) PG8_BAR; }
    PG8_BAR;
    if constexpr (Epi::AFTER_DRAIN) { E.fused(acc, cur, wr, wc, fr, fq, lds, wid, lane); S.done(cur); }
#undef PG8_SA
#undef PG8_SB
#undef PG8_STAGE
#undef PG8_LDA
#undef PG8_LDB
#undef PG8_MMA
#undef PG8_WAIT_V
#undef PG8_WAIT_L
#undef PG8_BAR
#undef PG8_SCHED
}
}

#ifndef PG8_SP2
#define PG8_SP2 true
#endif
#ifndef PG8_ALIGN
#define PG8_ALIGN true
#endif
#define GAS __attribute__((address_space(1)))
#define LAS __attribute__((address_space(3)))
typedef unsigned short bf16;
typedef unsigned v4u __attribute__((ext_vector_type(4)));
typedef float f32x4 __attribute__((ext_vector_type(4)));
typedef short bf16x8 __attribute__((ext_vector_type(8)));
typedef GAS unsigned gu32;
typedef GAS unsigned long long gu64;
#define RLX_AGENT __ATOMIC_RELAXED, __HIP_MEMORY_SCOPE_AGENT
#define LDS_WAIT() asm volatile("s_waitcnt lgkmcnt(0)" ::: "memory")
#define VM_WAIT() asm volatile("s_waitcnt vmcnt(0)" ::: "memory")
__device__ __forceinline__ unsigned long long rt() { return __builtin_amdgcn_s_memrealtime(); }
__device__ __forceinline__ unsigned f2bf(float f) { unsigned u = __builtin_bit_cast(unsigned, f); return (u + 0x7fffu + ((u >> 16) & 1u)) >> 16; }
__device__ __forceinline__ unsigned pk2(float lo, float hi) { return f2bf(lo) | (f2bf(hi) << 16); }

#define XB_TMO      128
#define XB_XCNT(j)  (256  + 64 * (j))
#define XB_XSUB(j)  (1280 + 64 * (j))
#define XB_XGEN(j)  (2304 + 64 * (j))
#define XB_TOP      3328
#define XB_TOPGEN   3392
#define XCD_BAR_WORDS 3456
#define XB_SPIN_CAP (1u << 18)

__device__ __forceinline__ unsigned xb_ld(unsigned* p)              { return __hip_atomic_load(p, __ATOMIC_RELAXED, __HIP_MEMORY_SCOPE_AGENT); }
__device__ __forceinline__ unsigned xb_add(unsigned* p, unsigned v) { return __hip_atomic_fetch_add(p, v, __ATOMIC_RELAXED, __HIP_MEMORY_SCOPE_AGENT); }
__device__ __forceinline__ unsigned xb_xcc_id() { return (unsigned)__builtin_amdgcn_s_getreg((3 << 11) | 20) & 0xFu; }
#define XB_SPIN(cond, bar) do { unsigned _sp = 0; while (cond) { __builtin_amdgcn_s_sleep(1); \
    if ((++_sp & 255u) == 0u) { if (xb_ld(&(bar)[XB_TMO])) break; if (_sp > XB_SPIN_CAP) { atomicAdd(&(bar)[XB_TMO], 1u); break; } } } } while (0)

struct XcdBarrier {
    unsigned* bar; unsigned x;
    unsigned G;
    unsigned wv;
    volatile LAS unsigned* st;
};

__device__ __forceinline__ XcdBarrier xcd_barrier_post(unsigned* bar, volatile LAS unsigned* st, unsigned wv, unsigned G = 0u) {
    XcdBarrier b; b.bar = bar; b.x = xb_xcc_id(); b.st = st; b.G = G; b.wv = wv;
    if (wv == 0u && lane_id_() == 0) (void)xb_add(&bar[XB_XCNT(b.x)], 1u);
    return b;
}
__device__ __forceinline__ void xcd_barrier_complete(unsigned* bar, unsigned x, unsigned& nloc, unsigned& nx, unsigned Gp) {
    const unsigned G = Gp ? Gp : gridDim.x * gridDim.y * gridDim.z;
    unsigned sum, cnt, mine, sp = 0u;
    for (;;) {
        sum = 0u; cnt = 0u; mine = 0u;
#pragma unroll
        for (unsigned j = 0; j < 16; ++j) { const unsigned c = xb_ld(&bar[XB_XCNT(j)]); sum += c; cnt += (c > 0u) ? 1u : 0u; mine = (j == x) ? c : mine; }
        if (sum == G) break;
        __builtin_amdgcn_s_sleep(1);
        if ((++sp & 255u) == 0u) { if (xb_ld(&bar[XB_TMO])) break; if (sp > XB_SPIN_CAP) { atomicAdd(&bar[XB_TMO], 1u); break; } }
    }
    nloc = mine > 0u ? mine : 1u; nx = cnt > 0u ? cnt : 1u;
}

__device__ __forceinline__ void xcd_barrier(const XcdBarrier& b) {
    asm volatile("s_waitcnt vmcnt(0)" ::: "memory");
    __syncthreads();
    if (b.wv == 0u && lane_id_() == 0) {
        unsigned* bar = b.bar;
        __builtin_amdgcn_s_waitcnt(0);
        unsigned nloc = b.st[0], nx = b.st[1];
        if (nloc == 0u) { xcd_barrier_complete(bar, b.x, nloc, nx, b.G); b.st[0] = nloc; b.st[1] = nx; }
        const unsigned old = xb_add(&bar[XB_XSUB(b.x)], 1u);
        const unsigned gen = old / nloc;
        if (old + 1u == (gen + 1u) * nloc) {
            __builtin_amdgcn_fence(__ATOMIC_RELEASE, "agent");
            asm volatile("s_waitcnt vmcnt(0)" ::: "memory");
            const unsigned og = xb_add(&bar[XB_TOP], 1u);
            const unsigned tg = og / nx;
            if (og + 1u == (tg + 1u) * nx) xb_add(&bar[XB_TOPGEN], 1u);
            else XB_SPIN(xb_ld(&bar[XB_TOPGEN]) == tg, bar);
            __builtin_amdgcn_fence(__ATOMIC_ACQUIRE, "agent");
            xb_add(&bar[XB_XGEN(b.x)], 1u);
            asm volatile("s_waitcnt vmcnt(0)" ::: "memory");
        } else {
            XB_SPIN(xb_ld(&bar[XB_XGEN(b.x)]) == gen, bar);
            __builtin_amdgcn_fence(__ATOMIC_ACQUIRE, "agent");
            asm volatile("s_waitcnt vmcnt(0)" ::: "memory");
        }
    }
    __syncthreads();
}

constexpr int NWAVES = 8;
constexpr int BATCH = 8, SEQ = 8192, D = 1024, FF = 2816;
constexpr int M = BATCH * SEQ;
constexpr int NGU = 2 * FF;
constexpr int PW = 3584;
constexpr int PROJ_ORIG = 3344;
constexpr int RB = 1600, GLA_ORIG_W = 1552;
constexpr int NLORA = 1536, KLORA = 256;
constexpr int NIN = 27;
constexpr size_t MiB = 1u << 20;
constexpr size_t WS_CTL = 0, CTL_ZERO_BYTES = MiB / 2;
constexpr size_t WS_WGU1 = 2 * MiB, WS_WD1 = 14 * MiB, WS_WIN = 20 * MiB, WS_WOUT = 28 * MiB, WS_WGU2 = 30 * MiB, WS_WD2 = 42 * MiB, WS_WLORA = 48 * MiB;
constexpr size_t WS_SSP0 = 50 * MiB, WS_SSP1 = 54 * MiB, WS_SSP2 = 58 * MiB, WS_SSP3 = 62 * MiB;
constexpr size_t WS_XB = 68 * MiB;
constexpr size_t WS_Y = WS_XB;
constexpr size_t WS_OG = WS_XB + 64 * MiB;
constexpr size_t WS_HP = 196 * MiB;
constexpr size_t WS_MIXED = 644 * MiB;
constexpr size_t WS_LORA = 772 * MiB;
constexpr size_t WS_ALORA = 964 * MiB;
constexpr size_t WS_RS = 996 * MiB;
constexpr size_t WS_END = 998 * MiB;
constexpr int CW_BAR = 4096;
constexpr int CW_PROG = 65536;
static_assert((size_t)(CW_PROG + 64 * (801 + 2 * 7) + 1) * 4 <= CTL_ZERO_BYTES, "control words inside the zeroed region");
constexpr int NSUB = 224;
constexpr int RING_OFF = 0, RING_BYTES = 147456, AUX_OFF = 131072;
constexpr int LDSCTL_OFF = RING_BYTES, MISC_OFF = LDSCTL_OFF + 320;
constexpr int LDS_BYTES = 151552;

struct Frame {
    LAS unsigned char* lds;
    volatile LAS unsigned* MISC;
    gu32* ctl;
    int tid, lane, wave;
    int vcu, G;
};
__device__ __forceinline__ float wave_sum(float v) {
#pragma unroll
    for (int o = 1; o < 64; o <<= 1) v += __shfl_xor(v, o);
    return v;
}
template <int MAP> __device__ __forceinline__ int rowmap(int n) {
    if (MAP == 1) return ((n >> 7) << 8) + (n & 127);
    if (MAP == 2) return ((n >> 7) << 8) + 128 + (n & 127);
    if (MAP == 3) return n < GLA_ORIG_W ? n : n + (RB - GLA_ORIG_W);
    return n;
}
template <int MAP> __device__ __forceinline__ void p0_item(const float* W, const float* gain, int K, int N, bf16* WT, LAS float* scr, int item, int lane) {
    const int nblk = (N + 31) / 32, kb = item / nblk, nb = item % nblk, k0 = 64 * kb, n0 = 32 * nb;
    const int nn = n0 + (lane & 31);
    float wv[32];
#pragma unroll
    for (int i = 0; i < 32; ++i) { const int kk = 2 * i + (lane >> 5); wv[i] = 0.f; if (nn < N) wv[i] = W[(size_t)(k0 + kk) * N + nn]; }
#pragma unroll
    for (int i = 0; i < 32; ++i) { const int kk = 2 * i + (lane >> 5); float v = wv[i]; if (gain) v *= gain[k0 + kk]; scr[kk * 33 + (lane & 31)] = v; }
    LDS_WAIT(); asm volatile("" ::: "memory");
    const int c = lane & 7;
#pragma unroll
    for (int j = 0; j < 4; ++j) { const int nl = (lane >> 3) + 8 * j; const LAS float* s = scr + (8 * c) * 33 + nl;
        v4u o; o.x = pk2(s[0 * 33], s[1 * 33]); o.y = pk2(s[2 * 33], s[3 * 33]); o.z = pk2(s[4 * 33], s[5 * 33]); o.w = pk2(s[6 * 33], s[7 * 33]);
        if (n0 + nl < N) *(GAS v4u*)(WT + (size_t)rowmap<MAP>(n0 + nl) * K + k0 + 8 * c) = o; }
    LDS_WAIT(); asm volatile("" ::: "memory");
}
struct Args { const float* in[NIN]; float* out; unsigned char* ws; int ph_lo, ph_hi, li, pad; };
static_assert(sizeof(Args) == NIN * 8 + 8 + 8 + 16, "Args has no padding");

__device__ __forceinline__ void p0_prologue(Frame& F, const Args& a) {
    LAS float* scr = (LAS float*)(F.lds + RING_OFF + F.wave * 16384);
    const int gw = F.vcu * NWAVES + F.wave, NGW = F.G * NWAVES;
    unsigned char* ws = a.ws;
    constexpr int I_GU = (D / 64) * (FF / 32), I_DN = (FF / 64) * (D / 32), I_IN = (D / 64) * ((PROJ_ORIG + 31) / 32), I_OUT = (D / 64) * (D / 32);
    constexpr int NITEMS = 2 * (2 * I_GU + I_DN) + I_IN + I_OUT;
    for (int it = gw; it < NITEMS; it += NGW) {
        int r = it;
        if (r < I_GU) { p0_item<1>(a.in[2], a.in[1], D, FF, (bf16*)(ws + WS_WGU1), scr, r, F.lane); continue; } r -= I_GU;
        if (r < I_GU) { p0_item<2>(a.in[3], a.in[1], D, FF, (bf16*)(ws + WS_WGU1), scr, r, F.lane); continue; } r -= I_GU;
        if (r < I_DN) { p0_item<0>(a.in[4], nullptr, FF, D, (bf16*)(ws + WS_WD1), scr, r, F.lane); continue; } r -= I_DN;
        if (r < I_GU) { p0_item<1>(a.in[23], a.in[22], D, FF, (bf16*)(ws + WS_WGU2), scr, r, F.lane); continue; } r -= I_GU;
        if (r < I_GU) { p0_item<2>(a.in[24], a.in[22], D, FF, (bf16*)(ws + WS_WGU2), scr, r, F.lane); continue; } r -= I_GU;
        if (r < I_DN) { p0_item<0>(a.in[25], nullptr, FF, D, (bf16*)(ws + WS_WD2), scr, r, F.lane); continue; } r -= I_DN;
        if (r < I_IN) { p0_item<3>(a.in[6], a.in[5], D, PROJ_ORIG, (bf16*)(ws + WS_WIN), scr, r, F.lane); continue; } r -= I_IN;
        p0_item<0>(a.in[21], nullptr, D, D, (bf16*)(ws + WS_WOUT), scr, r, F.lane);
    }
    { const int gt = gw * 64 + F.lane;
      if (gt < NLORA * (KLORA / 8)) { const int n = gt >> 5, kc = gt & 31, type = n >> 9, nl = n & 511; float v[8];
#pragma unroll
          for (int q = 0; q < 8; ++q) { const int k = 8 * kc + q; float x = 0.f;
              if (type == 0) { if (k < 64) x = a.in[12][k * 512 + nl]; } else if (type == 1) { if (k >= 64 && k < 128) x = a.in[14][(k - 64) * 512 + nl]; } else { if (k >= 128) x = a.in[15][(k - 128) * 512 + nl]; }
              v[q] = x; }
          v4u o; o.x = pk2(v[0], v[1]); o.y = pk2(v[2], v[3]); o.z = pk2(v[4], v[5]); o.w = pk2(v[6], v[7]);
          *(GAS v4u*)((bf16*)(ws + WS_WLORA) + (size_t)n * KLORA + 8 * kc) = o; } }
    const float* x = a.in[0]; bf16* xb = (bf16*)(ws + WS_XB); float* ssp = (float*)(ws + WS_SSP0);
#pragma unroll 4
    for (int m = gw; m < M; m += NGW) {
        const GAS f32x4* xr = (const GAS f32x4*)(x + (size_t)m * D) + F.lane;
        f32x4 v[4]; float s = 0.f;
#pragma unroll
        for (int j = 0; j < 4; ++j) { v[j] = xr[64 * j]; s += (v[j].x * v[j].x + v[j].y * v[j].y) + (v[j].z * v[j].z + v[j].w * v[j].w); }
        s = wave_sum(s);
        GAS unsigned long long* o8 = (GAS unsigned long long*)(xb + (size_t)m * D) + F.lane;
#pragma unroll
        for (int j = 0; j < 4; ++j) o8[64 * j] = (unsigned long long)pk2(v[j].x, v[j].y) | ((unsigned long long)pk2(v[j].z, v[j].w) << 32);
        if (F.lane < 16) ssp[(size_t)m * 16 + F.lane] = (F.lane == 0) ? s : 0.f;
    }
}
__device__ __forceinline__ void final_norm(Frame& F, const Args& a) {
    const int gw = F.vcu * NWAVES + F.wave, NGW = F.G * NWAVES;
    const float* ssp = (const float*)(a.ws + WS_SSP3); const float* g = a.in[26]; const bf16* xb = (const bf16*)(a.ws + WS_XB);
    f32x4 gv[4];
#pragma unroll
    for (int j = 0; j < 4; ++j) gv[j] = ((const GAS f32x4*)g)[F.lane + 64 * j];
#pragma unroll 2
    for (int m = gw; m < M; m += NGW) {
        float s = ssp[(size_t)m * 16 + (F.lane & 15)];
        s += __shfl_xor(s, 1); s += __shfl_xor(s, 2); s += __shfl_xor(s, 4); s += __shfl_xor(s, 8);
        const float rs = rsqrtf(s * (1.0f / 1024.0f) + 1e-6f);
        const GAS unsigned long long* xr = (const GAS unsigned long long*)(xb + (size_t)m * D) + F.lane;
        GAS f32x4* orow = (GAS f32x4*)(a.out + (size_t)m * D) + F.lane;
        unsigned long long w[4];
#pragma unroll
        for (int j = 0; j < 4; ++j) w[j] = xr[64 * j];
#pragma unroll
        for (int j = 0; j < 4; ++j) { const unsigned lo = (unsigned)w[j], hi = (unsigned)(w[j] >> 32);
            f32x4 v = {__builtin_bit_cast(float, lo << 16), __builtin_bit_cast(float, lo & 0xffff0000u), __builtin_bit_cast(float, hi << 16), __builtin_bit_cast(float, hi & 0xffff0000u)};
            orow[64 * j] = v * rs * gv[j]; }
    }
}


__device__ __forceinline__ float bf2f(bf16 v) { return __builtin_bit_cast(float, (unsigned)v << 16); }
__device__ __forceinline__ bf16 f2bf16(float f) { return (bf16)f2bf(f); }

namespace rw {
typedef float f32x2 __attribute__((ext_vector_type(2)));
template <int CTRL> __device__ __forceinline__ float dpp_mov(float x) { return __builtin_bit_cast(float, __builtin_amdgcn_update_dpp(0, __builtin_bit_cast(int, x), CTRL, 0xF, 0xF, true)); }
__device__ __forceinline__ float red16(float x) { x += dpp_mov<0xB1>(x); x += dpp_mov<0x4E>(x); x += dpp_mov<0x141>(x); x += dpp_mov<0x140>(x); return x; }
__device__ __forceinline__ void unpack8(const v4u w, float (&o)[8]) {
    o[0] = __builtin_bit_cast(float, w.x << 16); o[1] = __builtin_bit_cast(float, w.x & 0xffff0000u); o[2] = __builtin_bit_cast(float, w.y << 16); o[3] = __builtin_bit_cast(float, w.y & 0xffff0000u);
    o[4] = __builtin_bit_cast(float, w.z << 16); o[5] = __builtin_bit_cast(float, w.z & 0xffff0000u); o[6] = __builtin_bit_cast(float, w.w << 16); o[7] = __builtin_bit_cast(float, w.w & 0xffff0000u);
}
__device__ __forceinline__ float red8(float x) { x += dpp_mov<0xB1>(x); x += dpp_mov<0x4E>(x); x += dpp_mov<0x141>(x); return x; }
__device__ __forceinline__ void post_rows(Frame& F, const Args& args, int m0, int nrows) {
    const int lane = F.lane;
    const bf16* proj = (const bf16*)(args.ws + WS_HP); const bf16* lora = (const bf16*)(args.ws + WS_LORA); bf16* mixed = (bf16*)(args.ws + WS_MIXED);
    int c8 = 8 * lane;
    asm volatile("" : "+v"(c8));
    float mur[8], muk[8], muv[8], kac[8], rkc[8], lw[8], lb[8], nw[8];
#pragma unroll
    for (int q = 0; q < 8; ++q) { mur[q] = args.in[10][c8 + q]; muk[q] = args.in[10][512 + c8 + q]; muv[q] = args.in[10][1024 + c8 + q]; kac[q] = args.in[17][c8 + q]; rkc[q] = args.in[18][c8 + q];
        lw[q] = args.in[19][c8 + q]; lb[q] = args.in[20][c8 + q]; nw[q] = args.in[9][(c8 & 127) + q]; }
#pragma unroll 2
    for (int m = m0 + F.wave; m < m0 + nrows; m += NWAVES) {
        const bf16* p = proj + (size_t)m * PW + RB + c8; const bool has_prev = (m % SEQ) != 0; const bf16* pp = has_prev ? p - PW : p;
        const v4u wy = *(const v4u*)(mixed + (size_t)m * D + 512 + c8), wr_ = *(const v4u*)p, wk = *(const v4u*)(p + 512), wv = *(const v4u*)(p + 1024);
        const v4u qr = *(const v4u*)pp, qk = *(const v4u*)(pp + 512), qv = *(const v4u*)(pp + 1024);
        const v4u wa = *(const v4u*)(lora + (size_t)m * NLORA + 512 + c8), wg = *(const v4u*)(lora + (size_t)m * NLORA + 1024 + c8);
        const v4u wo = *(const v4u*)(mixed + (size_t)m * D + c8), wgo = *(const v4u*)(proj + (size_t)m * PW + 1024 + c8);
        float y[8], cr[8], ck[8], cv[8], pr[8], pk_[8], pv[8], a[8], g[8], o[8], go[8];
        unpack8(wy, y); unpack8(wr_, cr); unpack8(wk, ck); unpack8(wv, cv); unpack8(qr, pr); unpack8(qk, pk_); unpack8(qv, pv); unpack8(wa, a); unpack8(wg, g); unpack8(wo, o); unpack8(wgo, go);
        float vv[8], bsum = 0.f, ysum = 0.f;
#pragma unroll
        for (int q = 0; q < 8; ++q) { const float pq = has_prev ? pr[q] : 0.f, pkq = has_prev ? pk_[q] : 0.f, pvq = has_prev ? pv[q] : 0.f;
            const float r = cr[q] + mur[q] * (pq - cr[q]), k = ck[q] + muk[q] * (pkq - ck[q]); vv[q] = cv[q] + muv[q] * (pvq - cv[q]);
            const float kp = k * (1.0f + (a[q] - 1.0f) * kac[q]); bsum += r * kp * rkc[q]; ysum += y[q]; }
        const float bonus = red8(bsum), mean = red8(ysum) * (1.0f / 64.0f);
        float vsum = 0.f;
#pragma unroll
        for (int q = 0; q < 8; ++q) { y[q] -= mean; vsum += y[q] * y[q]; }
        const float rstd = rsqrtf(red8(vsum) * (1.0f / 64.0f) + 64e-5f);
        float res[8];
#pragma unroll
        for (int q = 0; q < 8; ++q) res[q] = (y[q] * rstd * lw[q] + lb[q] + bonus * vv[q]) * g[q];
        v4u ow; ow.x = pk2(res[0], res[1]); ow.y = pk2(res[2], res[3]); ow.z = pk2(res[4], res[5]); ow.w = pk2(res[6], res[7]);
        *(v4u*)(mixed + (size_t)m * D + 512 + c8) = ow;
        float osq = 0.f;
#pragma unroll
        for (int q = 0; q < 8; ++q) osq += o[q] * o[q];
        const float rs = rsqrtf(red16(osq) * (1.0f / 128.0f) + 1e-6f);
#pragma unroll
        for (int q = 0; q < 8; ++q) res[q] = o[q] * rs * nw[q] * go[q] * pg8::fsigmoid(go[q]);
        ow.x = pk2(res[0], res[1]); ow.y = pk2(res[2], res[3]); ow.z = pk2(res[4], res[5]); ow.w = pk2(res[6], res[7]);
        *(v4u*)(mixed + (size_t)m * D + c8) = ow;
    }
}
}

namespace rk {
typedef short bf16x8 __attribute__((ext_vector_type(8)));
typedef unsigned u32x2 __attribute__((ext_vector_type(2)));
constexpr int CB = 16, NBLK = SEQ / CB, NSLOT = 8, NCH = 2;
constexpr int P64 = 72, P32 = 40;
constexpr int O_AI = 0, O_RI = 2304, O_BT = 4608, O_KT = 6912, O_BK = 4608  , O_PS = 9728, O_MAK = 11008, O_TI = 12288, O_MR = 13568, O_VT = 14848, O_EG = 16896, SLOT = 17152;
constexpr int O_FLAGS = NSLOT * SLOT;
constexpr int O_STG = O_FLAGS + 64;
static_assert(O_STG + NCH * 1024 <= RING_BYTES, "rwkv chunk LDS map");
__device__ __forceinline__ float ubf(unsigned v) { return __builtin_bit_cast(float, v << 16); }
typedef __bf16 bf2_t __attribute__((ext_vector_type(2)));
__device__ __forceinline__ unsigned pk(float lo, float hi) { bf2_t v = {(__bf16)lo, (__bf16)hi}; return __builtin_bit_cast(unsigned, v); }
__device__ __forceinline__ bf16x8 mk8(unsigned a, unsigned b, unsigned c, unsigned d) { v4u t; t.x = a; t.y = b; t.z = c; t.w = d; return __builtin_bit_cast(bf16x8, t); }
__device__ __forceinline__ bf16x8 fr64(const LAS unsigned char* base, int row, int k0) { return *(const LAS bf16x8*)(base + (row * P64 + k0) * 2); }
__device__ __forceinline__ bf16x8 fr32(const LAS unsigned char* base, int row, int k0) { return *(const LAS bf16x8*)(base + (row * P32 + k0) * 2); }
__device__ __forceinline__ void store16_wt(bf16* p, v4u v) { asm volatile("global_store_dwordx4 %0, %1, off sc1\n\ts_nop 1" :: "v"((GAS v4u*)p), "v"(v) : "memory"); }
__device__ __forceinline__ void stage_put(LAS bf16* stg, f32x4 Y, int s, int fr, int fq) { const unsigned y01 = pk(Y[0], Y[1]), y23 = pk(Y[2], Y[3]); LAS bf16* o = stg + (4 * fq) * 32 + 16 * s + fr;
    o[0] = (bf16)(y01 & 0xffffu); o[32] = (bf16)(y01 >> 16); o[64] = (bf16)(y23 & 0xffffu); o[96] = (bf16)(y23 >> 16); }
__device__ __forceinline__ void stage_flush(const LAS bf16* stg, bf16* tile  , int lane) {
    asm volatile("s_waitcnt lgkmcnt(0)" ::: "memory"); const v4u v = *(const LAS v4u*)(stg + lane * 8); store16_wt(tile + (size_t)(lane >> 2) * D + 8 * (lane & 3), v); }
#define RK_MFMA(a, b, c) __builtin_amdgcn_mfma_f32_16x16x32_bf16(a, b, c, 0, 0, 0)
struct Raw { unsigned r[CB], k[CB], v[CB], ld[CB], a[CB], pr, pk_, pv; float rsv; };
struct Ctx { const bf16* proj; const bf16* lora; const float* rsn; bf16* Y; int mb, hc, h; float mur, muk, muv, kkc, kac; __amdgpu_buffer_rsrc_t pr, lr; };

#define RK_LD16(rs, vo, so) ((unsigned)(unsigned short)__builtin_amdgcn_raw_buffer_load_b16(rs, vo, so, 0))
__device__ __forceinline__ void prod_load(Raw& R, const Ctx& c, int blk, int j) {
    const int blkc = blk < NBLK ? blk : NBLK - 1; const int t0 = blkc * CB; const unsigned vo = (unsigned)j * 2u;
    const unsigned so = (unsigned)(((c.mb + t0) * PW + RB + c.hc) * 2), sl = (unsigned)(((c.mb + t0) * NLORA + c.hc) * 2);
    const unsigned sop = t0 > 0 ? so - (unsigned)(PW * 2) : so;
    R.pr = RK_LD16(c.pr, vo, sop); R.pk_ = RK_LD16(c.pr, vo + 1024u, sop); R.pv = RK_LD16(c.pr, vo + 2048u, sop);
#pragma unroll
    for (int i = 0; i < CB; ++i) { const unsigned si = so + (unsigned)(i * PW * 2), li = sl + (unsigned)(i * NLORA * 2);
        R.r[i] = RK_LD16(c.pr, vo, si); R.k[i] = RK_LD16(c.pr, vo + 1024u, si); R.v[i] = RK_LD16(c.pr, vo + 2048u, si); R.ld[i] = RK_LD16(c.lr, vo, li); R.a[i] = RK_LD16(c.lr, vo + 1024u, li); }
    R.rsv = c.rsn[(size_t)(c.mb + t0 + (j & 15)) * 8 + c.h];
}
__device__ __forceinline__ void put_prime(LAS unsigned char* img, f32x4 m, int fr, int fq, int off) {
    LAS bf16* q = (LAS bf16*)img + (4 * fq) * P32 + 8 * (fr >> 2) + (fr & 3) + off;
    const unsigned lo = pk(m[0], m[1]), hi = pk(m[2], m[3]);
    q[0] = (bf16)(lo & 0xffffu); q[P32] = (bf16)(lo >> 16); q[2 * P32] = (bf16)(hi & 0xffffu); q[3 * P32] = (bf16)(hi >> 16);
}
__device__ __forceinline__ void produce(Raw& R, const Ctx& c, LAS unsigned char* sp, int blk, int nextblk, int lane) {
    const int j = lane, fr = lane & 15, fq = lane >> 4;
    const int pj = 32 * (j >> 5) + 8 * ((j >> 2) & 3) + 4 * ((j >> 4) & 1) + (j & 3);
    LAS bf16* const AI = (LAS bf16*)(sp + O_AI) + pj; LAS bf16* const RI = (LAS bf16*)(sp + O_RI) + pj; LAS bf16* const BT = (LAS bf16*)(sp + O_BT) + pj; LAS bf16* const KT = (LAS bf16*)(sp + O_KT) + pj;
    const bool first = blk == 0;
    float pr = first ? 0.f : ubf(R.pr), pk0 = first ? 0.f : ubf(R.pk_), pv = first ? 0.f : ubf(R.pv);
    float G = 0.f, e0 = 1.0f; float bm[CB], km[CB]; unsigned vpk[CB / 2]; float vprev = 0.f;
#pragma unroll
    for (int i = 0; i < CB; ++i) {
        const float cr = ubf(R.r[i]), ck = ubf(R.k[i]), cv = ubf(R.v[i]);
        const float r = cr + c.mur * (pr - cr), k = ck + c.muk * (pk0 - ck), vv = cv + c.muv * (pv - cv);
        pr = cr; pk0 = ck; pv = cv;
        const float al = ubf(R.a[i]);
        G += ubf(R.ld[i]);
        const float e1 = __expf(G), em = __builtin_amdgcn_rcpf(e1);
        const float kk = k * c.kkc * __builtin_bit_cast(float, __builtin_amdgcn_readlane(__builtin_bit_cast(int, R.rsv), i));
        const float kp = k * (1.0f + (al - 1.0f) * c.kac), bb = kk * al;
        const unsigned ar = pk(-kk * e0, r * e1); bm[i] = bb * em; km[i] = kp * em; const unsigned bk = pk(bm[i], km[i]);
        AI[i * P64] = (bf16)(ar & 0xffffu); RI[i * P64] = (bf16)(ar >> 16); BT[i * P64] = (bf16)(bk & 0xffffu); KT[i * P64] = (bf16)(bk >> 16);
        if (i & 1) vpk[i >> 1] = pk(vprev, vv); else vprev = vv;
        e0 = e1;
    }
    const float eg = e0;
    prod_load(R, c, nextblk, j);
    asm volatile("s_waitcnt lgkmcnt(0)" ::: "memory");
    const bf16x8 a0 = fr64(sp + O_AI, fr, 8 * fq), a1 = fr64(sp + O_AI, fr, 32 + 8 * fq), r0 = fr64(sp + O_RI, fr, 8 * fq), r1 = fr64(sp + O_RI, fr, 32 + 8 * fq);
    const bf16x8 b0 = fr64(sp + O_BT, fr, 8 * fq), b1 = fr64(sp + O_BT, fr, 32 + 8 * fq), k0 = fr64(sp + O_KT, fr, 8 * fq), k1 = fr64(sp + O_KT, fr, 32 + 8 * fq);
    const f32x4 z = {0.f, 0.f, 0.f, 0.f};
    f32x4 Mab = RK_MFMA(a1, b1, RK_MFMA(a0, b0, z)), Mak = RK_MFMA(a1, k1, RK_MFMA(a0, k0, z)), Mrb = RK_MFMA(r1, b1, RK_MFMA(r0, b0, z)), Mrk = RK_MFMA(r1, k1, RK_MFMA(r0, k0, z));
#pragma unroll
    for (int q = 0; q < 4; ++q) { const int t = 4 * fq + q; const bool st = fr < t, in = fr <= t; Mab[q] = st ? Mab[q] : 0.f; Mak[q] = st ? Mak[q] : 0.f; Mrb[q] = in ? Mrb[q] : 0.f; Mrk[q] = in ? Mrk[q] : 0.f; }
    put_prime(sp + O_MAK, Mak, fr, fq, 0); put_prime(sp + O_MR, Mrb, fr, fq, 0); put_prime(sp + O_MR, Mrk, fr, fq, 4);
    f32x4 P = Mab, Tc = Mab;
#pragma unroll
    for (int q = 0; q < 4; ++q) if (fr == 4 * fq + q) Tc[q] += 1.0f;
    put_prime(sp + O_PS, P, fr, fq, 0); put_prime(sp + O_TI, Tc, fr, fq, 0);
#pragma unroll
    for (int it = 0; it < 3; ++it) {
        asm volatile("s_waitcnt lgkmcnt(0)" ::: "memory");
        const bf16x8 Pa = fr32(sp + O_PS, fr, 8 * fq), Ta = fr32(sp + O_TI, fr, 8 * fq);
        const bf16x8 Pb = mk8(pk(P[0], P[1]), pk(P[2], P[3]), 0u, 0u);
        const f32x4 P2 = RK_MFMA(Pa, Pb, z);
        const bf16x8 P2b = mk8(pk(P2[0], P2[1]), pk(P2[2], P2[3]), 0u, 0u);
        Tc = RK_MFMA(Ta, P2b, Tc);
        P = P2;
        asm volatile("s_waitcnt lgkmcnt(0)" ::: "memory");
        if (it < 2) put_prime(sp + O_PS, P, fr, fq, 0);
        put_prime(sp + O_TI, Tc, fr, fq, 0);
    }
    asm volatile("s_waitcnt lgkmcnt(0)" ::: "memory");
    { LAS v4u* bkrow = (LAS v4u*)(sp + O_BK + j * (P32 * 2));
#pragma unroll
      for (int q = 0; q < 4; ++q) { v4u o; o.x = pk(bm[4 * q], bm[4 * q + 1]); o.y = pk(bm[4 * q + 2], bm[4 * q + 3]); o.z = pk(km[4 * q], km[4 * q + 1]); o.w = pk(km[4 * q + 2], km[4 * q + 3]); bkrow[q] = o; }
      LAS v4u* vtrow = (LAS v4u*)(sp + O_VT + j * 32);
      v4u o0; o0.x = vpk[0]; o0.y = vpk[1]; o0.z = vpk[2]; o0.w = vpk[3]; vtrow[0] = o0; v4u o1; o1.x = vpk[4]; o1.y = vpk[5]; o1.z = vpk[6]; o1.w = vpk[7]; vtrow[1] = o1;
      ((LAS float*)(sp + O_EG))[j] = eg; }
}
__device__ __forceinline__ void chain_block(f32x4 (&S)[2][4], const LAS unsigned char* sp, LAS bf16* stg, bf16* ytile, int cw, int fr, int fq) {
    const bf16x8 ai0 = fr64(sp + O_AI, fr, 8 * fq), ai1 = fr64(sp + O_AI, fr, 32 + 8 * fq), ri0 = fr64(sp + O_RI, fr, 8 * fq), ri1 = fr64(sp + O_RI, fr, 32 + 8 * fq);
    const bf16x8 mak = fr32(sp + O_MAK, fr, 8 * fq), ti = fr32(sp + O_TI, fr, 8 * fq), mr = fr32(sp + O_MR, fr, 8 * fq);
    bf16x8 bk[4]; f32x4 eg[4];
#pragma unroll
    for (int mt = 0; mt < 4; ++mt) { bk[mt] = fr32(sp + O_BK, 16 * mt + fr, 8 * fq); eg[mt] = *(const LAS f32x4*)(sp + O_EG + (16 * mt + 4 * fq) * 4); }
    const f32x4 z = {0.f, 0.f, 0.f, 0.f};
#pragma unroll
    for (int s = 0; s < 2; ++s) {
        const bf16x8 Sf0 = mk8(pk(S[s][0][0], S[s][0][1]), pk(S[s][0][2], S[s][0][3]), pk(S[s][1][0], S[s][1][1]), pk(S[s][1][2], S[s][1][3]));
        const bf16x8 Sf1 = mk8(pk(S[s][2][0], S[s][2][1]), pk(S[s][2][2], S[s][2][3]), pk(S[s][3][0], S[s][3][1]), pk(S[s][3][2], S[s][3][3]));
        const u32x2 vh = *(const LAS u32x2*)(sp + O_VT + (32 * cw + 16 * s + fr) * 32 + 8 * fq);
        f32x4 U0 = RK_MFMA(ai0, Sf0, z); U0 = RK_MFMA(ai1, Sf1, U0); U0 = RK_MFMA(mak, mk8(vh.x, vh.y, 0u, 0u), U0);
        const f32x4 U = RK_MFMA(ti, mk8(pk(U0[0], U0[1]), pk(U0[2], U0[3]), 0u, 0u), z);
        const bf16x8 UV = mk8(pk(U[0], U[1]), pk(U[2], U[3]), vh.x, vh.y);
        f32x4 Y = RK_MFMA(ri0, Sf0, z); Y = RK_MFMA(ri1, Sf1, Y); Y = RK_MFMA(mr, UV, Y);
        stage_put(stg, Y, s, fr, fq);
#pragma unroll
        for (int mt = 0; mt < 4; ++mt) S[s][mt] = RK_MFMA(bk[mt], UV, S[s][mt]) * eg[mt];
    }
    stage_flush(stg, ytile, fr + 16 * fq);
}
#define RK_SPIN(cond) do { unsigned sp_ = 0; while (cond) { __builtin_amdgcn_s_sleep(1); if (++sp_ > (1u << 22)) break; } asm volatile("" ::: "memory"); } while (0)
__device__ __forceinline__ void chunk_phase(Frame& F, const Args& args, int head) {
    const int b = head >> 3, h = head & 7, j = F.lane, fr = F.lane & 15, fq = F.lane >> 4;
    Ctx c; c.proj = (const bf16*)(args.ws + WS_HP); c.lora = (const bf16*)(args.ws + WS_LORA); c.Y = (bf16*)(args.ws + WS_MIXED);     c.mb = b * SEQ; c.hc = h * 64; c.h = h; c.rsn = (const float*)(args.ws + WS_RS);
    c.pr = __builtin_amdgcn_make_buffer_rsrc((void*)c.proj, 0, (int)((size_t)M * PW * 2), 0x00020000); c.lr = __builtin_amdgcn_make_buffer_rsrc((void*)c.lora, 0, (int)((size_t)M * NLORA * 2), 0x00020000);
    c.mur = args.in[10][c.hc + j]; c.muk = args.in[10][512 + c.hc + j]; c.muv = args.in[10][1024 + c.hc + j]; c.kkc = args.in[16][c.hc + j]; c.kac = args.in[17][c.hc + j];
    for (int u = F.tid; u < (O_FLAGS + 64) / 4; u += NWAVES * 64) ((LAS unsigned*)F.lds)[u] = 0u;
    __syncthreads();
    volatile LAS unsigned* const ready = (volatile LAS unsigned*)(F.lds + O_FLAGS); volatile LAS unsigned* const done = ready + NSLOT; LAS unsigned* const next = (LAS unsigned*)(F.lds + O_FLAGS) + NSLOT + NCH;
    if (F.wave < NCH) {
        const int cw = F.wave;
        f32x4 S[2][4];
#pragma unroll
        for (int s = 0; s < 2; ++s)
#pragma unroll
            for (int mt = 0; mt < 4; ++mt) S[s][mt] = (f32x4){0.f, 0.f, 0.f, 0.f};
#pragma unroll 1
        for (int blk = 0; blk < NBLK; ++blk) { const int slot = blk & (NSLOT - 1);
            RK_SPIN(ready[slot] != (unsigned)(blk + 1));
            chain_block(S, F.lds + slot * SLOT, (LAS bf16*)(F.lds + O_STG + cw * 1024), c.Y + (size_t)(c.mb + blk * CB) * D + 512 + c.hc + 32 * cw, cw, fr, fq);
            asm volatile("s_waitcnt lgkmcnt(0)" ::: "memory");
            if (F.lane == 0) done[cw] = (unsigned)(blk + 1);
            if ((blk & 15) == 15) {
                const int pn_ = blk >> 4;
                if (pn_ > 0) { asm volatile("s_waitcnt vmcnt(16)" ::: "memory"); if (F.lane == 0) __hip_atomic_fetch_add((unsigned*)(F.ctl + CW_PROG) + 64 * (b * 32 + pn_ - 1), 1u, __ATOMIC_RELAXED, __HIP_MEMORY_SCOPE_AGENT); }
                if (blk == NBLK - 1) { asm volatile("s_waitcnt vmcnt(0)" ::: "memory"); if (F.lane == 0) __hip_atomic_fetch_add((unsigned*)(F.ctl + CW_PROG) + 64 * (b * 32 + pn_), 1u, __ATOMIC_RELAXED, __HIP_MEMORY_SCOPE_AGENT); } }
        }
    } else {
        Raw R;
        unsigned g0 = 0u; if (F.lane == 0) g0 = __hip_atomic_fetch_add(next, 1u, __ATOMIC_RELAXED, __HIP_MEMORY_SCOPE_WORKGROUP);
        int blk = (int)__builtin_amdgcn_readfirstlane(g0);
        prod_load(R, c, blk, j);
#pragma unroll 1
        while (blk < NBLK) {
            unsigned g1 = 0u; if (F.lane == 0) g1 = __hip_atomic_fetch_add(next, 1u, __ATOMIC_RELAXED, __HIP_MEMORY_SCOPE_WORKGROUP);
            const int nblk = (int)__builtin_amdgcn_readfirstlane(g1);
            if (blk >= NSLOT) { const unsigned need = (unsigned)(blk - NSLOT + 1); RK_SPIN(done[0] < need || done[1] < need); }
            const int slot = blk & (NSLOT - 1);
            produce(R, c, F.lds + slot * SLOT, blk, nblk, F.lane);
            asm volatile("s_waitcnt lgkmcnt(0)" ::: "memory");
            if (F.lane == 0) ready[slot] = (unsigned)(blk + 1);
            blk = nblk;
        }
    }
}
#undef RK_SPIN
#undef RK_MFMA
}

namespace gk {
using rk::stage_put; using rk::stage_flush; using rk::bf16x8; using rk::u32x2; using rk::pk; using rk::mk8; using rk::fr64; using rk::fr32; using rk::ubf; using rk::put_prime;
constexpr int CB = 16, NBLK = SEQ / CB, RND = 4, NRND = NBLK / RND, P64 = rk::P64, P32 = rk::P32;
constexpr int O_RI = 0, O_KT = 2304, O_BK = 2304  , O_MR = 7424, O_VT = 8704, O_EG = 12800, SLOT = 13056, O_STG = 2 * RND * SLOT;
static_assert(O_STG + 4 * 1024 <= RING_BYTES, "gla chunk LDS map");
#define GK_MFMA(a, b, c) __builtin_amdgcn_mfma_f32_16x16x32_bf16(a, b, c, 0, 0, 0)
struct Raw { unsigned q[CB], k[CB], la[CB], va[CB], vb[CB]; };
struct Ctx { const bf16* proj; const bf16* lap; bf16* OG; int mb, h; __amdgpu_buffer_rsrc_t pr; };

__device__ __forceinline__ void prod_load(Raw& R, const Ctx& c, int blk, int j) {
    const int blkc = blk < NBLK ? blk : NBLK - 1; const unsigned vo = (unsigned)j * 2u;
    const unsigned so = (unsigned)(((c.mb + blkc * CB) * PW) * 2);
    const unsigned oq = (unsigned)(c.h * 64 * 2), ol = (unsigned)((c.h == 0 ? 1536 : 3392 + 64 * (c.h - 1)) * 2)  , ov = (unsigned)((512 + c.h * 128) * 2);
#pragma unroll
    for (int i = 0; i < CB; ++i) { const unsigned si = so + (unsigned)(i * PW * 2);
        R.q[i] = RK_LD16(c.pr, vo, si + oq); R.k[i] = RK_LD16(c.pr, vo + 512u, si + oq); R.la[i] = RK_LD16(c.pr, vo, si + ol); R.va[i] = RK_LD16(c.pr, vo, si + ov); R.vb[i] = RK_LD16(c.pr, vo + 128u, si + ov); }
}
__device__ __forceinline__ void produce(Raw& R, const Ctx& c, LAS unsigned char* sp, int nextblk, int lane) {
    const int j = lane, fr = lane & 15, fq = lane >> 4;
    const int pj = 32 * (j >> 5) + 8 * ((j >> 2) & 3) + 4 * ((j >> 4) & 1) + (j & 3);
    LAS bf16* const RI = (LAS bf16*)(sp + O_RI) + pj; LAS bf16* const KT = (LAS bf16*)(sp + O_KT) + pj;
    float G = 0.f, e1 = 1.0f; float km[CB]; unsigned va[CB / 2], vb[CB / 2];
#pragma unroll
    for (int i = 0; i < CB; ++i) {
        G += ubf(R.la[i]);
        e1 = __expf(G); const float em = __builtin_amdgcn_rcpf(e1);
        km[i] = ubf(R.k[i]) * em;
        const unsigned qk = pk(ubf(R.q[i]) * 0.125f * e1, km[i]);
        RI[i * P64] = (bf16)(qk & 0xffffu); KT[i * P64] = (bf16)(qk >> 16);
        if (i & 1) { va[i >> 1] = R.va[i - 1] | (R.va[i] << 16); vb[i >> 1] = R.vb[i - 1] | (R.vb[i] << 16); }
    }
    const float eg = e1;
    prod_load(R, c, nextblk, j);
    asm volatile("s_waitcnt lgkmcnt(0)" ::: "memory");
    const bf16x8 a0 = fr64(sp + O_RI, fr, 8 * fq), a1 = fr64(sp + O_RI, fr, 32 + 8 * fq), k0 = fr64(sp + O_KT, fr, 8 * fq), k1 = fr64(sp + O_KT, fr, 32 + 8 * fq);
    const f32x4 z = {0.f, 0.f, 0.f, 0.f};
    f32x4 Mqk = GK_MFMA(a1, k1, GK_MFMA(a0, k0, z));
#pragma unroll
    for (int q = 0; q < 4; ++q) Mqk[q] = (fr <= 4 * fq + q) ? Mqk[q] : 0.f;
    put_prime(sp + O_MR, Mqk, fr, fq, 4);
    asm volatile("s_waitcnt lgkmcnt(0)" ::: "memory");
    { LAS v4u* bkrow = (LAS v4u*)(sp + O_BK + j * (P32 * 2));
#pragma unroll
      for (int q = 0; q < 4; ++q) { v4u o; o.x = 0u; o.y = 0u; o.z = pk(km[4 * q] * eg, km[4 * q + 1] * eg); o.w = pk(km[4 * q + 2] * eg, km[4 * q + 3] * eg); bkrow[q] = o; }
      LAS v4u* vta = (LAS v4u*)(sp + O_VT + j * 32); LAS v4u* vtb = (LAS v4u*)(sp + O_VT + (j + 64) * 32);
      v4u o; o.x = va[0]; o.y = va[1]; o.z = va[2]; o.w = va[3]; vta[0] = o; o.x = va[4]; o.y = va[5]; o.z = va[6]; o.w = va[7]; vta[1] = o;
      o.x = vb[0]; o.y = vb[1]; o.z = vb[2]; o.w = vb[3]; vtb[0] = o; o.x = vb[4]; o.y = vb[5]; o.z = vb[6]; o.w = vb[7]; vtb[1] = o;
      ((LAS float*)(sp + O_EG))[j] = eg; }
}
__device__ __forceinline__ void chain_block(f32x4 (&S)[2][4], const LAS unsigned char* sp, LAS bf16* stg, bf16* otile, int cw, int fr, int fq) {
    const bf16x8 ri0 = fr64(sp + O_RI, fr, 8 * fq), ri1 = fr64(sp + O_RI, fr, 32 + 8 * fq), mr = fr32(sp + O_MR, fr, 8 * fq);
    bf16x8 bk[4];
#pragma unroll
    for (int mt = 0; mt < 4; ++mt) bk[mt] = fr32(sp + O_BK, 16 * mt + fr, 8 * fq);
    f32x4 eg[4];
#pragma unroll
    for (int mt = 0; mt < 4; ++mt) eg[mt] = *(const LAS f32x4*)(sp + O_EG + (16 * mt + 4 * fq) * 4);
    const f32x4 z = {0.f, 0.f, 0.f, 0.f};
#pragma unroll
    for (int s = 0; s < 2; ++s) {
        const bf16x8 Sf0 = mk8(pk(S[s][0][0], S[s][0][1]), pk(S[s][0][2], S[s][0][3]), pk(S[s][1][0], S[s][1][1]), pk(S[s][1][2], S[s][1][3]));
        const bf16x8 Sf1 = mk8(pk(S[s][2][0], S[s][2][1]), pk(S[s][2][2], S[s][2][3]), pk(S[s][3][0], S[s][3][1]), pk(S[s][3][2], S[s][3][3]));
        const u32x2 vh = *(const LAS u32x2*)(sp + O_VT + (32 * cw + 16 * s + fr) * 32 + 8 * fq);
        const bf16x8 V0 = mk8(0u, 0u, vh.x, vh.y);
        f32x4 Y = GK_MFMA(ri0, Sf0, z); Y = GK_MFMA(ri1, Sf1, Y); Y = GK_MFMA(mr, V0, Y);
        stage_put(stg, Y, s, fr, fq);
#pragma unroll
        for (int mt = 0; mt < 4; ++mt) S[s][mt] = GK_MFMA(bk[mt], V0, S[s][mt] * eg[mt]);
    }
    stage_flush(stg, otile, fr + 16 * fq);
}
__device__ __forceinline__ void chunk_phase(Frame& F, const Args& args, int blk_) {
    const int b = blk_ >> 2, h = blk_ & 3, j = F.lane, fr = F.lane & 15, fq = F.lane >> 4;
    Ctx c; c.proj = (const bf16*)(args.ws + WS_HP); c.lap = nullptr; c.OG = (bf16*)(args.ws + WS_MIXED);     c.mb = b * SEQ; c.h = h; c.pr = __builtin_amdgcn_make_buffer_rsrc((void*)c.proj, 0, (int)((size_t)M * PW * 2), 0x00020000);
    for (int u = F.tid; u < 2 * RND * SLOT / 4; u += NWAVES * 64) ((LAS unsigned*)F.lds)[u] = 0u;
    __syncthreads();
    const bool producer = F.wave >= 4; const int pw = F.wave & 3, cw = F.wave & 3;
    f32x4 S[2][4];
#pragma unroll
    for (int s = 0; s < 2; ++s)
#pragma unroll
        for (int mt = 0; mt < 4; ++mt) S[s][mt] = (f32x4){0.f, 0.f, 0.f, 0.f};
    Raw R;
    if (producer) { prod_load(R, c, pw, j); produce(R, c, F.lds + pw * SLOT, RND + pw, F.lane); }
    __syncthreads();
    for (int rnd = 0; rnd < NRND; ++rnd) {
        const int cur = rnd & 1;
        if (producer) { const int blk = RND * (rnd + 1) + pw; if (blk < NBLK) produce(R, c, F.lds + ((cur ^ 1) * RND + pw) * SLOT, blk + RND, F.lane); }
        else {
#pragma unroll 1
            for (int q = 0; q < RND; ++q) { const int blk = RND * rnd + q;
                chain_block(S, F.lds + (cur * RND + q) * SLOT, (LAS bf16*)(F.lds + O_STG + cw * 1024), c.OG + (size_t)(c.mb + blk * CB) * D + h * 128 + 32 * cw, cw, fr, fq);
                if ((blk & 15) == 15) { const int pn_ = blk >> 4;
                    if (pn_ > 0) { asm volatile("s_waitcnt vmcnt(16)" ::: "memory"); if (F.lane == 0) __hip_atomic_fetch_add((unsigned*)(F.ctl + CW_PROG) + 64 * (b * 32 + pn_ - 1), 1u, __ATOMIC_RELAXED, __HIP_MEMORY_SCOPE_AGENT); }
                    if (blk == NBLK - 1) { asm volatile("s_waitcnt vmcnt(0)" ::: "memory"); if (F.lane == 0) __hip_atomic_fetch_add((unsigned*)(F.ctl + CW_PROG) + 64 * (b * 32 + pn_), 1u, __ATOMIC_RELAXED, __HIP_MEMORY_SCOPE_AGENT); } } } }
        __syncthreads();
    }
}
#undef GK_MFMA
}
struct OneUnit { int pm, pn;
    __device__ __forceinline__ bool next(int i, pg8::Unit& u) const { if (i) return false; u.pm = pm; u.pn = pn; return true; }
    __device__ __forceinline__ void a_ready(const pg8::Unit&) const {}
    __device__ __forceinline__ void done(const pg8::Unit&) const {} };
__global__ void __launch_bounds__(NWAVES * 64, 2) skel_fwd(Args args) {
    extern __shared__ __attribute__((aligned(16))) unsigned char lds[];
    Frame F;
    F.lds = (LAS unsigned char*)lds;
    F.MISC = (volatile LAS unsigned*)(F.lds + MISC_OFF);
    F.tid = threadIdx.x; F.lane = F.tid & 63; F.wave = __builtin_amdgcn_readfirstlane(F.tid >> 6);
    F.G = gridDim.x; { const int bx = blockIdx.x; F.vcu = (F.G % 8 == 0) ? (bx % 8) * (F.G / 8) + bx / 8 : bx; }
    unsigned char* ws = args.ws;
    F.ctl = (gu32*)(ws + WS_CTL);
    for (int u = F.tid; u < (LDS_BYTES - LDSCTL_OFF) / 4; u += NWAVES * 64) ((LAS unsigned*)(F.lds + LDSCTL_OFF))[u] = 0u;
    __syncthreads();
    const int lo = args.ph_lo, hi = args.ph_hi;
    XcdBarrier bar; bar.bar = (unsigned*)(F.ctl + CW_BAR) + args.li * XCD_BAR_WORDS; bar.x = 0; bar.st = nullptr; bar.G = 0u; bar.wv = (unsigned)F.wave;
    XcdBarrier sub = bar;
    if (hi - lo > 1) { bar = xcd_barrier_post((unsigned*)(F.ctl + CW_BAR) + args.li * XCD_BAR_WORDS, F.MISC + 8, (unsigned)F.wave);
        if (blockIdx.x < NSUB) sub = xcd_barrier_post((unsigned*)(F.ctl + CW_BAR) + (2 + args.li) * XCD_BAR_WORDS, F.MISC + 10, (unsigned)F.wave, NSUB); }
#define IN(k) (lo <= (k) && (k) < hi)
#define BOTH(k) (IN(k) && (k) + 1 < hi && (k) != 11)
#define FRESH() do { F.lane = lane_id_(); F.tid = F.wave * 64 + F.lane; } while (0)
#define GRID_BAR() do { xcd_barrier(bar); FRESH(); } while (0)
    bf16* const XB = (bf16*)(ws + WS_XB); bf16* const HP = (bf16*)(ws + WS_HP); bf16* const MIXED = (bf16*)(ws + WS_MIXED);
    float* const SSP0 = (float*)(ws + WS_SSP0); float* const SSP1 = (float*)(ws + WS_SSP1); float* const SSP2 = (float*)(ws + WS_SSP2); float* const SSP3 = (float*)(ws + WS_SSP3);

    if (IN(0)) { p0_prologue(F, args); if (BOTH(0)) GRID_BAR(); }
    if (IN(1)) {
        pg8::Gemm g{XB, (const bf16*)(ws + WS_WGU1), M, NGU, D}; pg8::StaticOrder S; S.init(M, NGU, F.G, (int)blockIdx.x, 1);
        pg8::EpiGateUp E{HP, SSP0, FF, F.lds + AUX_OFF};
        pg8::gemm_phase<pg8::EpiGateUp, pg8::StaticOrder, PG8_ALIGN, PG8_SP2>(F.lds + RING_OFF, g, S, E, F.wave); FRESH();
        if (BOTH(1)) GRID_BAR();
    }
    if (IN(2)) {
        pg8::Gemm g{HP, (const bf16*)(ws + WS_WD1), M, D, FF}; pg8::StaticOrder S; S.init(M, D, F.G, (int)blockIdx.x, 0);
        pg8::EpiResid<true, false> E{nullptr, XB, nullptr, XB, SSP1, 0.5f};
        pg8::gemm_phase<pg8::EpiResid<true, false>, pg8::StaticOrder, PG8_ALIGN, PG8_SP2, true>(F.lds + RING_OFF, g, S, E, F.wave); FRESH();
        if (BOTH(2)) GRID_BAR();
    }
    if (IN(3)) {
        pg8::Gemm g{XB, (const bf16*)(ws + WS_WIN), M, PW, D}; pg8::StaticOrder S; S.init(M, PW, F.G, (int)blockIdx.x, 1);
        pg8::EpiRowScale E{HP, SSP1, PW, F.lds + AUX_OFF};
        pg8::gemm_phase<pg8::EpiRowScale, pg8::StaticOrder, PG8_ALIGN, PG8_SP2>(F.lds + RING_OFF, g, S, E, F.wave); FRESH();
        if (BOTH(3)) GRID_BAR();
    }
    if (IN(4)) {
        const int gw = F.vcu * NWAVES + F.wave, NGW = F.G * NWAVES; const float* mu = args.in[10] + 1536 + 4 * F.lane; bf16* AL = (bf16*)(ws + WS_ALORA);
        const f32x4 mu4 = *(const f32x4*)mu;
        f32x4 aw[16];
#pragma unroll
        for (int r = 0; r < 16; ++r) aw[r] = *(const f32x4*)(args.in[7] + r * 256 + 4 * F.lane);
        const f32x4 ab4 = *(const f32x4*)(args.in[8] + 4 * F.lane);
        float muk8[8], kk8[8];
#pragma unroll
        for (int q = 0; q < 8; ++q) { muk8[q] = args.in[10][512 + 8 * F.lane + q]; kk8[q] = args.in[16][8 * F.lane + q]; }
#pragma unroll 2
        for (int m = gw; m < M; m += NGW) {
            const bf16* p = HP + (size_t)m * PW + RB + 1536 + 4 * F.lane;
            const unsigned long long cw = *(const unsigned long long*)p; unsigned long long pw_ = 0ull; if ((m % SEQ) != 0) pw_ = *(const unsigned long long*)(p - PW);
            const v4u al0 = *(const v4u*)(HP + (size_t)m * PW + 1536), al1 = *(const v4u*)(HP + (size_t)m * PW + 1544);
            float o[4];
#pragma unroll
            for (int q = 0; q < 4; ++q) { const float cur = __builtin_bit_cast(float, (unsigned)((cw >> (16 * q)) & 0xffffull) << 16), prev = __builtin_bit_cast(float, (unsigned)((pw_ >> (16 * q)) & 0xffffull) << 16);
                const float ps = cur + mu4[q] * (prev - cur);
                o[q] = F.lane < 16 ? 2.0f * pg8::fsigmoid(2.0f * ps) - 1.0f : (F.lane < 32 ? ps : pg8::fsigmoid(ps)); }
            *(unsigned long long*)(AL + (size_t)m * KLORA + 4 * F.lane) = (unsigned long long)pk2(o[0], o[1]) | ((unsigned long long)pk2(o[2], o[3]) << 32);
            const unsigned alw[8] = {al0.x, al0.y, al0.z, al0.w, al1.x, al1.y, al1.z, al1.w};
            f32x4 lg = ab4;
#pragma unroll
            for (int q = 0; q < 8; ++q) { lg += aw[2 * q] * __builtin_bit_cast(float, alw[q] << 16); lg += aw[2 * q + 1] * __builtin_bit_cast(float, alw[q] & 0xffff0000u); }
            float la[4];
#pragma unroll
            for (int q = 0; q < 4; ++q) la[q] = (fminf(lg[q], 0.f) - __logf(1.0f + __expf(-fabsf(lg[q])))) * (1.0f / 16.0f);
            { const int hh = F.lane >> 4, cc = (4 * F.lane) & 63;
              *(unsigned long long*)(HP + (size_t)m * PW + (hh == 0 ? 1536 : 3392 + 64 * (hh - 1)) + cc) = (unsigned long long)pk2(la[0], la[1]) | ((unsigned long long)pk2(la[2], la[3]) << 32); }
            { const bf16* kp_ = HP + (size_t)m * PW + RB + 512 + 8 * F.lane; const v4u kc = *(const v4u*)kp_; v4u kq = {0u, 0u, 0u, 0u}; if ((m % SEQ) != 0) kq = *(const v4u*)(kp_ - PW);
              const unsigned kcw[4] = {kc.x, kc.y, kc.z, kc.w}, kqw[4] = {kq.x, kq.y, kq.z, kq.w}; float s2 = 0.f;
#pragma unroll
              for (int q = 0; q < 4; ++q) { const float c0 = __builtin_bit_cast(float, kcw[q] << 16), c1 = __builtin_bit_cast(float, kcw[q] & 0xffff0000u), p0 = __builtin_bit_cast(float, kqw[q] << 16), p1 = __builtin_bit_cast(float, kqw[q] & 0xffff0000u);
                  const float k0 = (c0 + muk8[2 * q] * (p0 - c0)) * kk8[2 * q], k1 = (c1 + muk8[2 * q + 1] * (p1 - c1)) * kk8[2 * q + 1]; s2 += k0 * k0 + k1 * k1; }
              s2 += rw::dpp_mov<0xB1>(s2); s2 += rw::dpp_mov<0x4E>(s2); s2 += rw::dpp_mov<0x141>(s2);
              if ((F.lane & 7) == 0) ((float*)(ws + WS_RS))[(size_t)m * 8 + (F.lane >> 3)] = rsqrtf(fmaxf(s2, 1e-24f)); }
        }
        if (BOTH(4)) GRID_BAR();
    }
    if (IN(5)) {
        const int bx = blockIdx.x;
        if (bx < NSUB) {
            int klora = KLORA / 2; asm volatile("" : "+s"(klora));
            { pg8::Gemm g{(const bf16*)(ws + WS_ALORA), (const bf16*)(ws + WS_WLORA), M, 1024, klora, KLORA}; pg8::StaticOrder S; S.init(M, 1024, NSUB, bx);
              pg8::EpiLora E{(bf16*)(ws + WS_LORA), args.in[11], args.in[13], 0};
              pg8::gemm_phase<pg8::EpiLora, pg8::StaticOrder, PG8_ALIGN, PG8_SP2>(F.lds + RING_OFF, g, S, E, F.wave); FRESH(); }
            xcd_barrier(sub);
            if (bx < 64) rk::chunk_phase(F, args, bx);
            else { pg8::Gemm g{(const bf16*)(ws + WS_ALORA) + KLORA / 2, (const bf16*)(ws + WS_WLORA) + (size_t)1024 * KLORA + KLORA / 2, M, 512, klora, KLORA}; pg8::StaticOrder S; S.init(M, 512, NSUB - 64, bx - 64);
              pg8::EpiLora E{(bf16*)(ws + WS_LORA), args.in[11], args.in[13], 4};
              pg8::gemm_phase<pg8::EpiLora, pg8::StaticOrder, PG8_ALIGN, PG8_SP2>(F.lds + RING_OFF, g, S, E, F.wave); FRESH();
              gu32* const prog = F.ctl + CW_PROG;
              asm volatile("s_waitcnt vmcnt(0)" ::: "memory"); __syncthreads();
              if (F.tid == 0) { __builtin_amdgcn_fence(__ATOMIC_RELEASE, "agent"); asm volatile("s_waitcnt vmcnt(0)" ::: "memory");
                  __hip_atomic_fetch_add((unsigned*)(prog + 64 * 256), 1u, __ATOMIC_RELAXED, __HIP_MEMORY_SCOPE_AGENT);
                  unsigned sp_ = 0; while (__hip_atomic_load((unsigned*)(prog + 64 * 256), __ATOMIC_RELAXED, __HIP_MEMORY_SCOPE_AGENT) < (unsigned)(NSUB - 64)) { __builtin_amdgcn_s_sleep(4); if (++sp_ > (1u << 21)) break; } }
              __syncthreads();
            }
        } else gk::chunk_phase(F, args, bx - NSUB);
        { gu32* const prog = F.ctl + CW_PROG;
          const int wb = bx < 64 ? (bx >> 3) : (bx < NSUB ? ((bx - 64) & 7) : ((bx - NSUB) >> 2));
          if (bx < 64 || bx >= NSUB) {
              if (F.tid == 0) { unsigned sp_ = 0; while (__hip_atomic_load((unsigned*)(prog + 64 * 256), __ATOMIC_RELAXED, __HIP_MEMORY_SCOPE_AGENT) < (unsigned)(NSUB - 64)) { __builtin_amdgcn_s_sleep(16); if (++sp_ > (1u << 20)) break; } }
              __syncthreads(); }
              constexpr int NPU = 4 * (SEQ / 256);
              unsigned* const qpost = (unsigned*)(prog + 64 * (800 + 2 * wb)); unsigned* const qgemm = (unsigned*)(prog + 64 * (801 + 2 * wb));
              volatile LAS unsigned* const wsel = F.MISC + 12;
#pragma unroll 1
              for (int it_ = 0; it_ < 2 * NPU + 2; ++it_) {
                  if (F.tid == 0) { unsigned sel = 0xffffffffu, sp_ = 0;
                      for (;;) {
                          unsigned pq = __hip_atomic_load(qpost, __ATOMIC_RELAXED, __HIP_MEMORY_SCOPE_AGENT);
                          if (pq < (unsigned)NPU) {
                              if (__hip_atomic_load((unsigned*)(prog + 64 * (wb * 32 + (pq >> 2))), __ATOMIC_RELAXED, __HIP_MEMORY_SCOPE_AGENT) >= 32u) {
                                  if (__hip_atomic_compare_exchange_strong(qpost, &pq, pq + 1u, __ATOMIC_RELAXED, __ATOMIC_RELAXED, __HIP_MEMORY_SCOPE_AGENT)) { sel = pq; break; }
                                  continue; } }
                          unsigned gq = __hip_atomic_load(qgemm, __ATOMIC_RELAXED, __HIP_MEMORY_SCOPE_AGENT);
                          if (gq < (unsigned)NPU) {
                              if (__hip_atomic_load((unsigned*)(prog + 64 * (512 + wb * 32 + (gq >> 2))), __ATOMIC_RELAXED, __HIP_MEMORY_SCOPE_AGENT) >= 4u) {
                                  if (__hip_atomic_compare_exchange_strong(qgemm, &gq, gq + 1u, __ATOMIC_RELAXED, __ATOMIC_RELAXED, __HIP_MEMORY_SCOPE_AGENT)) { sel = 0x40000000u | gq; break; }
                                  continue; } }
                          else break;
                          __builtin_amdgcn_s_sleep(127); if (++sp_ > (1u << 18)) break; }
                      wsel[0] = sel; }
                  __syncthreads();
                  const unsigned sel = (unsigned)__builtin_amdgcn_readfirstlane((int)wsel[0]);
                  __syncthreads();
                  if (sel == 0xffffffffu) break;
                  const int k = (int)(sel & 0xffffu), tp = k >> 2, pb = wb, qr = k & 3, panel = pb * (SEQ / 256) + tp;
                  if (!(sel & 0x40000000u)) {
                      if (F.tid == 0) { __builtin_amdgcn_fence(__ATOMIC_ACQUIRE, "agent"); asm volatile("s_waitcnt vmcnt(0)" ::: "memory"); }
                      __syncthreads();
                      rw::post_rows(F, args, pb * SEQ + 256 * tp + 64 * qr, 64);
                      asm volatile("s_waitcnt vmcnt(0)" ::: "memory"); __syncthreads();
                      if (F.tid == 0) { __builtin_amdgcn_fence(__ATOMIC_RELEASE, "agent"); asm volatile("s_waitcnt vmcnt(0)" ::: "memory");
                          __hip_atomic_fetch_add((unsigned*)(prog + 64 * (512 + panel)), 1u, __ATOMIC_RELAXED, __HIP_MEMORY_SCOPE_AGENT); }
                  } else {
                      if (F.tid == 0) { __builtin_amdgcn_fence(__ATOMIC_ACQUIRE, "agent"); asm volatile("s_waitcnt vmcnt(0)" ::: "memory"); }
                      __syncthreads();
                      pg8::Gemm g8{MIXED, (const bf16*)(ws + WS_WOUT), M, D, D}; OneUnit S8{panel, qr};
                      pg8::EpiResid<true, false> E8{nullptr, XB, nullptr, XB, SSP2, 1.0f};
                      pg8::gemm_phase<pg8::EpiResid<true, false>, OneUnit, PG8_ALIGN, PG8_SP2>(F.lds + RING_OFF, g8, S8, E8, F.wave); FRESH(); }
              }
        }
        if (BOTH(5)) GRID_BAR();
    }
    if (IN(9)) {
        pg8::Gemm g{XB, (const bf16*)(ws + WS_WGU2), M, NGU, D}; pg8::StaticOrder S; S.init(M, NGU, F.G, (int)blockIdx.x);
        pg8::EpiGateUp E{HP, SSP2, FF, F.lds + AUX_OFF};
        pg8::gemm_phase<pg8::EpiGateUp, pg8::StaticOrder, PG8_ALIGN, PG8_SP2>(F.lds + RING_OFF, g, S, E, F.wave); FRESH();
        if (BOTH(9)) GRID_BAR();
    }
    if (IN(10)) {
        pg8::Gemm g{HP, (const bf16*)(ws + WS_WD2), M, D, FF}; pg8::StaticOrder S; S.init(M, D, F.G, (int)blockIdx.x, 1);
        pg8::EpiResid<true, false> E{nullptr, XB, nullptr, XB, SSP3, 0.5f};
        pg8::gemm_phase<pg8::EpiResid<true, false>, pg8::StaticOrder, PG8_ALIGN, PG8_SP2, true>(F.lds + RING_OFF, g, S, E, F.wave); FRESH();
        if (BOTH(10)) GRID_BAR();
    }
    if (IN(11)) { final_norm(F, args); }
#undef IN
#undef BOTH
}

static void launch_skel(int grid, hipStream_t stream, Args a, int lo, int hi, int li = 0) {
    a.ph_lo = lo; a.ph_hi = hi; a.li = li;
    hipLaunchKernelGGL(skel_fwd, dim3(grid), dim3(NWAVES * 64), LDS_BYTES, stream, a);
}
extern "C" void kernel_launch(void* const* d_in, const int* in_sizes, int n_in, void* d_out, int out_size, void* d_ws, size_t ws_size, hipStream_t stream) {
    static int grid = 0;
    if (grid == 0) {
        if (n_in != NIN || in_sizes[0] != M * D || out_size != M * D || ws_size < WS_END) { fprintf(stderr, "kernel_launch: unexpected shapes (n_in %d, in0 %d, out %d, ws %zu)\n", n_in, n_in > 0 ? in_sizes[0] : -1, out_size, ws_size); grid = -1; return; }
        int dev = 0, cus = 0;
        if (hipGetDevice(&dev) != hipSuccess || hipDeviceGetAttribute(&cus, hipDeviceAttributeMultiprocessorCount, dev) != hipSuccess) { grid = -1; return; }
        if (hipFuncSetAttribute((const void*)skel_fwd, hipFuncAttributeMaxDynamicSharedMemorySize, LDS_BYTES) != hipSuccess) { fprintf(stderr, "kernel_launch: hipFuncSetAttribute failed\n"); grid = -1; return; }
        (void)hipGetLastError();
        grid = cus;
    }
    if (grid < 0) return;
    if (hipMemsetAsync((char*)d_ws + WS_CTL, 0, CTL_ZERO_BYTES, stream) != hipSuccess) return;
    Args a{};
    for (int i = 0; i < NIN; ++i) a.in[i] = (const float*)d_in[i];
    a.out = (float*)d_out; a.ws = (unsigned char*)d_ws;
    launch_skel(grid, stream, a, 0, 12);
}
```
